# Optimizing an MI355X kernel written in HIP

```python
import jax, jax.numpy as jnp
from jax import lax
import numpy as np

D_MODEL = 2048
BATCH = 4
SEQ = 4096
DEPTH = 2

GRID_W = 64
CTX_LEN = 256
HEAD_DIM = 128
EPS = 1e-6
N_MOD = 9
D_FF = 5504
LRU_WIDTH = D_MODEL // 2
LRU_BLOCKS = LRU_WIDTH // HEAD_DIM
CONV_W = 4
LRU_C = 8.0
ATT_HEADS = (D_MODEL // 2) // HEAD_DIM
ATT_KV_HEADS = ATT_HEADS // 4
WINDOW = 128
BLOCK = 128
ROPE_THETA = 10000.0
NA_HEADS = D_MODEL // HEAD_DIM
NA_D = NA_HEADS * HEAD_DIM
NA_KH = 8
NA_KW = 16
NA_COL_BLOCK = 16
NA_COL_SPAN = 2 * NA_KW
N_EVEN = (DEPTH + 1) // 2
N_ODD = DEPTH // 2
AB_IN = 2 * LRU_WIDTH + (ATT_HEADS + 2 * ATT_KV_HEADS) * HEAD_DIM
ATTN_SCALE = HEAD_DIM ** -0.5

kernel_name = "hybrid_rglru_swa_natten_prefix_dit"


def rmsnorm(x, g):
    x32 = x.astype(jnp.float32)
    y = x32 * lax.rsqrt(jnp.mean(x32 * x32, axis=-1, keepdims=True) + EPS)
    return (y * g).astype(x.dtype)


def modulate(h, shift, scale):
    return h * (1.0 + scale) + shift


def half_ffn(x, g, shift, scale, gate, w_in, w_out):
    h = modulate(rmsnorm(x, g), shift, scale)
    gt, up = jnp.split(h @ w_in, 2, axis=-1)
    return x + 0.5 * gate * ((jax.nn.silu(gt) * up) @ w_out)


def heads(t, n):
    return t.reshape(*t.shape[:-1], n, HEAD_DIM)


def axial_rope(x, pos_row, pos_col):
    half = HEAD_DIM // 2
    nf = half // 2
    inv = ROPE_THETA ** (-jnp.arange(nf, dtype=jnp.float32) / nf)

    def rot(xa, pos):
        ang = pos.astype(jnp.float32)[:, None] * inv[None, :]
        cos = jnp.cos(ang)[None, :, None, :]
        sin = jnp.sin(ang)[None, :, None, :]
        x1, x2 = xa[..., :nf], xa[..., nf:]
        return jnp.concatenate([x1 * cos - x2 * sin, x2 * cos + x1 * sin], axis=-1)

    return jnp.concatenate([rot(x[..., :half], pos_row), rot(x[..., half:], pos_col)],
                           axis=-1).astype(x.dtype)


def centred_depthwise_conv(u, w, b):
    L = u.shape[1]
    left = CONV_W // 2
    up = jnp.pad(u, ((0, 0), (left, CONV_W - 1 - left), (0, 0)))
    out = b
    for k in range(CONV_W):
        out = out + up[:, k:k + L] * w[k]
    return out


def rglru_coeffs(u, w_a, b_a, w_x, b_x, lam):
    ub = u.reshape(*u.shape[:-1], LRU_BLOCKS, HEAD_DIM)
    gate_r = jnp.einsum('blnc,ncd->blnd', ub, w_a).reshape(u.shape) + b_a
    gate_i = jnp.einsum('blnc,ncd->blnd', ub, w_x).reshape(u.shape) + b_x
    r = jax.nn.sigmoid(gate_r.astype(jnp.float32))
    i = jax.nn.sigmoid(gate_i.astype(jnp.float32))
    log_a = -LRU_C * r * jax.nn.softplus(-lam.astype(jnp.float32))
    a = jnp.exp(log_a)
    b = jnp.sqrt(-jnp.expm1(2.0 * log_a)) * (i * u.astype(jnp.float32))
    return a, b


def linear_scan(a, b, h0, reverse):
    def combine(e1, e2):
        a1, b1 = e1
        a2, b2 = e2
        return a1 * a2, a2 * b1 + b2

    a_cum, h = lax.associative_scan(combine, (a, b), axis=1, reverse=reverse)
    if h0 is not None:
        h = h + a_cum * h0[:, None]
    return h


def with_sink(s, sink):
    g = ATT_HEADS // ATT_KV_HEADS
    col = jnp.broadcast_to(sink.astype(jnp.float32).reshape(ATT_KV_HEADS, g, 1, 1),
                           s.shape[:-1] + (1,))
    return jnp.concatenate([s, col], axis=-1)


def windowed_gqa(q, k, v, kc, vc, sink):
    B, L, H, hd = q.shape
    nb = L // BLOCK
    g = H // ATT_KV_HEADS
    n_ctx = kc.shape[1]
    qb = q.reshape(B, nb, BLOCK, ATT_KV_HEADS, g, hd)

    def band(t):
        tp = jnp.pad(t, ((0, 0), (BLOCK, BLOCK), (0, 0), (0, 0)))
        tp = tp.reshape(B, nb + 2, BLOCK, ATT_KV_HEADS, hd)
        return jnp.concatenate([tp[:, :-2], tp[:, 1:-1], tp[:, 2:]], axis=2)

    kw, vw = band(k), band(v)
    nk = 3 * BLOCK
    s_loc = jnp.einsum('bnqkgd,bnskd->bnkgqs', qb, kw).astype(jnp.float32) * ATTN_SCALE
    qpos = np.arange(nb)[:, None] * BLOCK + np.arange(BLOCK)[None, :]
    kpos = (np.arange(nb)[:, None] - 1) * BLOCK + np.arange(nk)[None, :]
    valid = ((np.abs(qpos[:, :, None] - kpos[:, None, :]) <= WINDOW)
             & (kpos[:, None, :] >= 0) & (kpos[:, None, :] < L))
    s_loc = jnp.where(valid[None, :, None, None], s_loc, -jnp.inf)
    s_ctx = jnp.einsum('bnqkgd,bskd->bnkgqs', qb, kc).astype(jnp.float32) * ATTN_SCALE
    p = jax.nn.softmax(with_sink(jnp.concatenate([s_loc, s_ctx], axis=-1), sink), axis=-1)
    o = (jnp.einsum('bnkgqs,bnskd->bnqkgd', p[..., :nk].astype(v.dtype), vw)
         + jnp.einsum('bnkgqs,bskd->bnqkgd', p[..., nk:nk + n_ctx].astype(vc.dtype), vc))
    return o.reshape(B, L, H * hd)


def context_gqa(qc, kc, vc, sink):
    B, C, H, hd = qc.shape
    g = H // ATT_KV_HEADS
    qg = qc.reshape(B, C, ATT_KV_HEADS, g, hd)
    s = jnp.einsum('bqkgd,bskd->bkgqs', qg, kc).astype(jnp.float32) * ATTN_SCALE
    p = jax.nn.softmax(with_sink(s, sink), axis=-1)[..., :C]
    o = jnp.einsum('bkgqs,bskd->bqkgd', p.astype(vc.dtype), vc)
    return o.reshape(B, C, H * hd)


def mixer_ab(h_lat, h_ctx, w_in, conv_w, conv_b, w_a, b_a, w_x, b_x, lam,
             q_g, k_g, sink, w_out, pos_row, pos_col, ctx_out):
    splits = np.cumsum([LRU_WIDTH, LRU_WIDTH, ATT_HEADS * HEAD_DIM, ATT_KV_HEADS * HEAD_DIM]).tolist()
    xl_lat, gl_lat, q_lat, k_lat, v_lat = jnp.split(h_lat @ w_in, splits, axis=-1)
    if ctx_out:
        xl_ctx, gl_ctx, q_ctx, k_ctx, v_ctx = jnp.split(h_ctx @ w_in, splits, axis=-1)
    else:
        w_ctx = jnp.concatenate([w_in[:, :LRU_WIDTH], w_in[:, splits[2]:]], axis=1)
        xl_ctx, k_ctx, v_ctx = jnp.split(h_ctx @ w_ctx, [LRU_WIDTH, LRU_WIDTH + ATT_KV_HEADS * HEAD_DIM], axis=-1)

    u_lat = centred_depthwise_conv(xl_lat, conv_w, conv_b)
    u_ctx = centred_depthwise_conv(xl_ctx, conv_w, conv_b)
    h_lat_sum, h_ctx_sum = None, None
    for d, rev in enumerate((False, True)):
        a_c, b_c = rglru_coeffs(u_ctx, w_a[d], b_a[d], w_x[d], b_x[d], lam[d])
        hc = linear_scan(a_c, b_c, None, rev)
        h0 = hc[:, 0] if rev else hc[:, -1]
        a_l, b_l = rglru_coeffs(u_lat, w_a[d], b_a[d], w_x[d], b_x[d], lam[d])
        hl = linear_scan(a_l, b_l, h0, rev)
        h_lat_sum = hl if h_lat_sum is None else h_lat_sum + hl
        h_ctx_sum = hc if h_ctx_sum is None else h_ctx_sum + hc
    lru_lat = (h_lat_sum * jax.nn.gelu(gl_lat.astype(jnp.float32))).astype(h_lat.dtype)

    q_lat = axial_rope(rmsnorm(heads(q_lat, ATT_HEADS), q_g), pos_row, pos_col)
    k_lat = axial_rope(rmsnorm(heads(k_lat, ATT_KV_HEADS), k_g), pos_row, pos_col)
    v_lat = heads(v_lat, ATT_KV_HEADS)
    k_ctx = rmsnorm(heads(k_ctx, ATT_KV_HEADS), k_g)
    v_ctx = heads(v_ctx, ATT_KV_HEADS)
    att_lat = windowed_gqa(q_lat, k_lat, v_lat, k_ctx, v_ctx, sink)
    y_lat = jnp.concatenate([lru_lat, att_lat], axis=-1) @ w_out
    y_ctx = None
    if ctx_out:
        lru_ctx = (h_ctx_sum * jax.nn.gelu(gl_ctx.astype(jnp.float32))).astype(h_ctx.dtype)
        att_ctx = context_gqa(rmsnorm(heads(q_ctx, ATT_HEADS), q_g), k_ctx, v_ctx, sink)
        y_ctx = jnp.concatenate([lru_ctx, att_ctx], axis=-1) @ w_out
    return y_lat, y_ctx


def mixer_na(h_lat, h_ctx, w_in, q_g, k_g, rpb, w_out, ctx_out):
    B, L, _ = h_lat.shape
    rows = L // GRID_W
    kh = min(NA_KH, rows)
    q, k, v = jnp.split(h_lat @ w_in, 3, axis=-1)
    q = rmsnorm(heads(q, NA_HEADS), q_g)
    k = rmsnorm(heads(k, NA_HEADS), k_g)
    v = heads(v, NA_HEADS)
    if ctx_out:
        qc, kc, vc = jnp.split(h_ctx @ w_in, 3, axis=-1)
    else:
        kc, vc = jnp.split(h_ctx @ w_in[:, NA_D:], 2, axis=-1)
    kc = rmsnorm(heads(kc, NA_HEADS), k_g)
    vc = heads(vc, NA_HEADS)
    n_ctx = kc.shape[1]

    qg = q.reshape(B, rows, GRID_W, NA_HEADS, HEAD_DIM)
    kg = k.reshape(B, rows, GRID_W, NA_HEADS, HEAD_DIM)
    vg = v.reshape(B, rows, GRID_W, NA_HEADS, HEAD_DIM)

    ncb = GRID_W // NA_COL_BLOCK
    m_idx = np.arange(ncb)
    col_start = np.clip(m_idx * NA_COL_BLOCK - NA_KW // 2, 0, GRID_W - NA_COL_SPAN)
    key_col = col_start[:, None] + np.arange(NA_COL_SPAN)[None, :]
    q_col = m_idx[:, None] * NA_COL_BLOCK + np.arange(NA_COL_BLOCK)[None, :]
    win_start = np.clip(q_col - NA_KW // 2, 0, GRID_W - NA_KW)
    kcol = key_col[:, None, :]
    col_valid = (kcol >= win_start[..., None]) & (kcol < win_start[..., None] + NA_KW)
    col_off = np.clip(kcol - q_col[..., None] + NA_KW - 1, 0, 2 * NA_KW - 2)
    n_loc = kh * NA_COL_SPAN

    def row_step(r):
        rs = jnp.clip(r - kh // 2, 0, rows - kh)
        qr = lax.dynamic_index_in_dim(qg, r, axis=1, keepdims=False)
        kr = lax.dynamic_slice_in_dim(kg, rs, kh, axis=1)
        vr = lax.dynamic_slice_in_dim(vg, rs, kh, axis=1)
        kb = kr[:, :, key_col]
        vb = vr[:, :, key_col]
        qb = qr.reshape(B, ncb, NA_COL_BLOCK, NA_HEADS, HEAD_DIM)
        s_loc = jnp.einsum('bmqhd,bimshd->bhmqis', qb, kb).astype(jnp.float32) * ATTN_SCALE
        ro = rs + jnp.arange(kh) - r + (NA_KH - 1)
        bias = rpb[:, ro[:, None, None, None], col_off[None]]
        bias = jnp.transpose(bias, (0, 2, 3, 1, 4)).astype(jnp.float32)
        s_loc = jnp.where(col_valid[:, :, None, :], s_loc + bias, -jnp.inf)
        s_loc = s_loc.reshape(B, NA_HEADS, ncb, NA_COL_BLOCK, n_loc)
        s_ctx = jnp.einsum('bmqhd,bshd->bhmqs', qb, kc).astype(jnp.float32) * ATTN_SCALE
        p = jax.nn.softmax(jnp.concatenate([s_loc, s_ctx], axis=-1), axis=-1)
        p_loc = p[..., :n_loc].reshape(B, NA_HEADS, ncb, NA_COL_BLOCK, kh, NA_COL_SPAN)
        o = (jnp.einsum('bhmqis,bimshd->bmqhd', p_loc.astype(v.dtype), vb)
             + jnp.einsum('bhmqs,bshd->bmqhd', p[..., n_loc:].astype(vc.dtype), vc))
        return o.reshape(B, GRID_W, NA_D)

    out = lax.map(row_step, jnp.arange(rows, dtype=jnp.int32))
    y_lat = jnp.moveaxis(out, 0, 1).reshape(B, L, NA_D) @ w_out
    y_ctx = None
    if ctx_out:
        qc = rmsnorm(heads(qc, NA_HEADS), q_g)
        s = jnp.einsum('bqhd,bshd->bhqs', qc, kc).astype(jnp.float32) * ATTN_SCALE
        p = jax.nn.softmax(s, axis=-1)
        oc = jnp.einsum('bhqs,bshd->bqhd', p.astype(vc.dtype), vc)
        y_ctx = oc.reshape(B, n_ctx, NA_D) @ w_out
    return y_lat, y_ctx


def setup_inputs(seed: int = 0) -> dict:
    key = jax.random.key(seed)
    ks = iter(jax.random.split(key, 32))

    def nrm(shape, scale):
        return jax.random.normal(next(ks), shape, jnp.float32) * scale

    D = D_MODEL
    a_init = jax.random.uniform(next(ks), (N_EVEN, 2, LRU_WIDTH), jnp.float32, minval=0.9, maxval=0.999)
    s_init = a_init ** (1.0 / LRU_C)
    lru_lambda = jnp.log(s_init) - jnp.log1p(-s_init)
    return {
        "x": nrm((BATCH, SEQ, D), 1.0),
        "c": nrm((BATCH, D), 1.0),
        "ctx": nrm((BATCH, CTX_LEN, D), 1.0),
        "c_ctx": nrm((D,), 1.0),
        "w_mod": nrm((DEPTH, D, N_MOD * D), 0.5 * D ** -0.5),
        "b_mod": nrm((DEPTH, N_MOD * D), 0.01),
        "norm_g": 1.0 + nrm((DEPTH, 3, D), 0.05),
        "ffn_w_in": nrm((DEPTH, 2, D, 2 * D_FF), D ** -0.5),
        "ffn_w_out": nrm((DEPTH, 2, D_FF, D), D_FF ** -0.5),
        "ab_w_in": nrm((N_EVEN, D, AB_IN), D ** -0.5),
        "lru_conv_w": nrm((N_EVEN, CONV_W, LRU_WIDTH), CONV_W ** -0.5),
        "lru_conv_b": nrm((N_EVEN, LRU_WIDTH), 0.01),
        "lru_w_a": nrm((N_EVEN, 2, LRU_BLOCKS, HEAD_DIM, HEAD_DIM), HEAD_DIM ** -0.5),
        "lru_b_a": nrm((N_EVEN, 2, LRU_WIDTH), 0.01),
        "lru_w_x": nrm((N_EVEN, 2, LRU_BLOCKS, HEAD_DIM, HEAD_DIM), HEAD_DIM ** -0.5),
        "lru_b_x": nrm((N_EVEN, 2, LRU_WIDTH), 0.01),
        "lru_lambda": lru_lambda,
        "attn_q_norm": 1.0 + nrm((N_EVEN, HEAD_DIM), 0.05),
        "attn_k_norm": 1.0 + nrm((N_EVEN, HEAD_DIM), 0.05),
        "attn_sink": nrm((N_EVEN, ATT_HEADS), 0.5),
        "ab_w_out": nrm((N_EVEN, LRU_WIDTH + ATT_HEADS * HEAD_DIM, D), (LRU_WIDTH + ATT_HEADS * HEAD_DIM) ** -0.5),
        "na_w_in": nrm((N_ODD, D, 3 * NA_D), D ** -0.5),
        "na_q_norm": 1.0 + nrm((N_ODD, HEAD_DIM), 0.05),
        "na_k_norm": 1.0 + nrm((N_ODD, HEAD_DIM), 0.05),
        "na_rpb": nrm((N_ODD, NA_HEADS, 2 * NA_KH - 1, 2 * NA_KW - 1), 0.1),
        "na_w_out": nrm((N_ODD, NA_D, D), NA_D ** -0.5),
    }


def reference(x, c, ctx, c_ctx, w_mod, b_mod, norm_g, ffn_w_in, ffn_w_out,
              ab_w_in, lru_conv_w, lru_conv_b, lru_w_a, lru_b_a, lru_w_x, lru_b_x, lru_lambda,
              attn_q_norm, attn_k_norm, attn_sink, ab_w_out,
              na_w_in, na_q_norm, na_k_norm, na_rpb, na_w_out):
    B, L, D = x.shape
    pos = jnp.arange(L, dtype=jnp.int32)
    pos_row, pos_col = pos // GRID_W, pos % GRID_W
    x_lat, x_ctx = x, ctx
    for l in range(DEPTH):
        ctx_out = l < DEPTH - 1
        m_lat = (jax.nn.silu(c) @ w_mod[l] + b_mod[l]).reshape(B, N_MOD, D)[:, :, None, :]
        m_ctx = (jax.nn.silu(c_ctx) @ w_mod[l] + b_mod[l]).reshape(N_MOD, D)
        x_lat = half_ffn(x_lat, norm_g[l, 0], m_lat[:, 0], m_lat[:, 1], m_lat[:, 2], ffn_w_in[l, 0], ffn_w_out[l, 0])
        x_ctx = half_ffn(x_ctx, norm_g[l, 0], m_ctx[0], m_ctx[1], m_ctx[2], ffn_w_in[l, 0], ffn_w_out[l, 0])
        h_lat = modulate(rmsnorm(x_lat, norm_g[l, 1]), m_lat[:, 3], m_lat[:, 4])
        h_ctx = modulate(rmsnorm(x_ctx, norm_g[l, 1]), m_ctx[3], m_ctx[4])
        if l % 2 == 0:
            e = l // 2
            y_lat, y_ctx = mixer_ab(h_lat, h_ctx, ab_w_in[e], lru_conv_w[e], lru_conv_b[e],
                                    lru_w_a[e], lru_b_a[e], lru_w_x[e], lru_b_x[e], lru_lambda[e],
                                    attn_q_norm[e], attn_k_norm[e], attn_sink[e], ab_w_out[e],
                                    pos_row, pos_col, ctx_out)
        else:
            o = l // 2
            y_lat, y_ctx = mixer_na(h_lat, h_ctx, na_w_in[o], na_q_norm[o], na_k_norm[o],
                                    na_rpb[o], na_w_out[o], ctx_out)
        x_lat = x_lat + m_lat[:, 5] * y_lat
        x_lat = half_ffn(x_lat, norm_g[l, 2], m_lat[:, 6], m_lat[:, 7], m_lat[:, 8], ffn_w_in[l, 1], ffn_w_out[l, 1])
        if ctx_out:
            x_ctx = x_ctx + m_ctx[5] * y_ctx
            x_ctx = half_ffn(x_ctx, norm_g[l, 2], m_ctx[6], m_ctx[7], m_ctx[8], ffn_w_in[l, 1], ffn_w_out[l, 1])
    return x_lat
```

```cpp
#include <hip/hip_runtime.h>
#include <cstdio>
#include <cstdint>
namespace pg8 {
#define PG8_LAS __attribute__((address_space(3)))
typedef unsigned short bf16_t;
typedef short bf16x8 __attribute__((ext_vector_type(8)));
typedef float f32x4 __attribute__((ext_vector_type(4)));
typedef unsigned u32x4 __attribute__((ext_vector_type(4)));
constexpr int BM = 256, BK = 64, HALF = 128, HTB = HALF * BK * 2  , STAGE_BYTES = 8 * HTB, NXCD = 8, WGM = 8;

__host__ __device__ __forceinline__ int lds_byte(int r, int c) { const int st = (r >> 4) * 2 + (c >> 5), rr = r & 15, cc = c & 31, ob = rr * 64 + cc * 2; return st * 1024 + (ob ^ (((ob >> 9) & 1) << 5)); }
__host__ __device__ __forceinline__ void stage_rc(int b, int& R, int& C) { const int st = b / 1024, sb = b % 1024, swz = sb ^ (((sb >> 9) & 1) << 5); R = (st >> 1) * 16 + swz / 64; C = (st & 1) * 32 + (swz % 64) / 2; }
__host__ __device__ __forceinline__ int perm32(int rho) { const int n = rho >> 4, i = rho & 15; return 8 * (i >> 2) + 4 * n + (i & 3); }

struct Unit { int pm, pn; };
struct Gemm { const bf16_t* A; const bf16_t* Bt; int M, N, K; };

struct StaticOrder {
    int nM, nN, nwg, G, c;
    __host__ __device__ void init(int M, int N, int G_, int c_) { nM = M / BM; nN = N / BM; nwg = nM * nN; G = G_; c = c_; }
    __host__ __device__ bool next(int i, Unit& u) const {
        const long L = (long)i * G + c; if (L >= nwg) return false;
        int wgid = (int)L; { const int q = nwg / NXCD, r = nwg % NXCD, xcd = wgid % NXCD, off = wgid / NXCD; wgid = (xcd < r ? xcd * (q + 1) : r * (q + 1) + (xcd - r) * q) + off; }
        const int nig = WGM * nN, gid = wgid / nig, fm = gid * WGM, gsz = (nM - fm) < WGM ? (nM - fm) : WGM;
        u.pm = fm + ((wgid % nig) % gsz); u.pn = (wgid % nig) / gsz; return true;
    }
    __device__ __forceinline__ void a_ready(const Unit&) const {}
    __device__ __forceinline__ void done(const Unit&) const {}
};
__device__ __forceinline__ unsigned cvt_pk_bf16(float lo, float hi) { unsigned r; asm volatile("v_cvt_pk_bf16_f32 %0, %1, %2" : "=v"(r) : "v"(lo), "v"(hi)); return r; }
typedef float f32x2 __attribute__((ext_vector_type(2)));
__device__ __forceinline__ float silu_f(float x) { return x * __builtin_amdgcn_rcpf(1.0f + __builtin_amdgcn_exp2f(-1.4426950408889634f * x)); }
struct EpiBf16 {
    static constexpr bool PERM = true, AFTER_DRAIN = false;
    bf16_t* O; int ldc;
    __device__ __forceinline__ void operator()(const f32x4 (&acc)[2][2][4][2], const Unit& u, int wr, int wc, int fr, int fq) const {
        const int row0 = u.pm * BM + wr * 64 + fr, col0 = u.pn * BM + wc * 32 + 8 * fq;
#pragma unroll
        for (int ai = 0; ai < 2; ++ai)
#pragma unroll
            for (int m = 0; m < 4; ++m) { bf16_t* rowp = O + (size_t)(row0 + ai * HALF + m * 16) * ldc + col0;
#pragma unroll
                for (int bj = 0; bj < 2; ++bj) { const f32x4 v0 = acc[ai][bj][m][0], v1 = acc[ai][bj][m][1];
                    u32x4 w; w.x = cvt_pk_bf16(v0[0], v0[1]); w.y = cvt_pk_bf16(v0[2], v0[3]); w.z = cvt_pk_bf16(v1[0], v1[1]); w.w = cvt_pk_bf16(v1[2], v1[3]);
                    *(u32x4*)(rowp + bj * HALF) = w; } }
    }
};
struct EpiSwiGLU {
    static constexpr bool PERM = true, AFTER_DRAIN = false;
    bf16_t* O; int ldc;
    __device__ __forceinline__ void operator()(const f32x4 (&acc)[2][2][4][2], const Unit& u, int wr, int wc, int fr, int fq) const {
        const int row0 = u.pm * BM + wr * 64 + fr, col0 = u.pn * HALF + wc * 32 + 8 * fq;
#pragma unroll
        for (int ai = 0; ai < 2; ++ai)
#pragma unroll
            for (int m = 0; m < 4; ++m) { bf16_t* rowp = O + (size_t)(row0 + ai * HALF + m * 16) * ldc + col0;
                const f32x4 g0 = acc[ai][0][m][0], g1 = acc[ai][0][m][1], u0 = acc[ai][1][m][0], u1 = acc[ai][1][m][1];
                u32x4 w; w.x = cvt_pk_bf16(silu_f(g0[0]) * u0[0], silu_f(g0[1]) * u0[1]); w.y = cvt_pk_bf16(silu_f(g0[2]) * u0[2], silu_f(g0[3]) * u0[3]);
                w.z = cvt_pk_bf16(silu_f(g1[0]) * u1[0], silu_f(g1[1]) * u1[1]); w.w = cvt_pk_bf16(silu_f(g1[2]) * u1[2], silu_f(g1[3]) * u1[3]);
                *(u32x4*)rowp = w; }
    }
};
struct EpiResid {
    static constexpr bool PERM = false, AFTER_DRAIN = false;
    const float* src_lat; const float* src_ctx; float* dst_lat; float* dst_ctx; const float* gate; float gs;
    __device__ __forceinline__ void operator()(const f32x4 (&acc)[2][2][4][2], const Unit& u, int wr, int wc, int fr, int fq) const {
        const int rl = wr * 64 + fr, col0 = u.pn * BM + wc * 32 + 4 * fq;
        const bool lat = u.pm < 64; const int slot = lat ? (u.pm >> 4) : 4;
        const float* gp = gate + (size_t)slot * (9 * 2048) + col0;
        const float* sb = (lat ? src_lat + (size_t)u.pm * BM * 2048 : src_ctx + (size_t)(u.pm - 64) * BM * 2048) + (size_t)rl * 2048 + col0;
        float* db = (lat ? dst_lat + (size_t)u.pm * BM * 2048 : dst_ctx + (size_t)(u.pm - 64) * BM * 2048) + (size_t)rl * 2048 + col0;
        f32x4 gv[2][2];
#pragma unroll
        for (int bj = 0; bj < 2; ++bj)
#pragma unroll
            for (int n = 0; n < 2; ++n) gv[bj][n] = *(const f32x4*)(gp + bj * HALF + n * 16) * gs;
#pragma unroll
        for (int ai = 0; ai < 2; ++ai)
#pragma unroll
            for (int m = 0; m < 4; ++m) { const size_t off = (size_t)(ai * HALF + m * 16) * 2048;
#pragma unroll
                for (int bj = 0; bj < 2; ++bj)
#pragma unroll
                    for (int n = 0; n < 2; ++n) { const f32x4 x = *(const f32x4*)(sb + off + bj * HALF + n * 16); *(f32x4*)(db + off + bj * HALF + n * 16) = x + gv[bj][n] * acc[ai][bj][m][n]; }
                asm volatile("" ::: "memory"); }
    }
};
template <class Epi, class Sched, bool ALIGN_EPI = false, bool SP2 = false>
__device__ __forceinline__ void gemm_phase(PG8_LAS unsigned char* lds, const Gemm g, const Sched& S, const Epi& E) {
    int tid = threadIdx.x; asm volatile("" : "+v"(tid));
    const int wid = __builtin_amdgcn_readfirstlane(tid >> 6), lane = tid & 63, wr = wid >> 2, wc = wid & 3, fr = lane & 15, fq = lane >> 4;
    const int K = g.K, nt = K / BK;
    unsigned voffA[2], voffB[2];
#pragma unroll
    for (int i = 0; i < 2; ++i) { int R, C; stage_rc(tid * 16 + i * 8192, R, C); const int Rb = Epi::PERM ? ((R & ~31) + perm32(R & 31)) : R;
        voffA[i] = (unsigned)(R * K + C) * 2u; voffB[i] = (unsigned)(Rb * K + C) * 2u; }
    const size_t kstep = (size_t)(BK * 2);
    const size_t hstep = (size_t)HALF * K * 2;
    const size_t tstep = 2 * hstep;
    const unsigned ldsw = (unsigned)wid * 1024u;
    const int aoff = lds_byte(wr * 64 + fr, fq * 8), boff = lds_byte(wc * 32 + fr, fq * 8);
#define PG8_SA(b, h) (((b) * 2 + (h)) * HTB)
#define PG8_SB(b, h) ((4 + (b) * 2 + (h)) * HTB)
#define PG8_STAGE(bufoff, gbase, voff) do { _Pragma("unroll") for (int _i = 0; _i < 2; ++_i) \
        __builtin_amdgcn_global_load_lds((const unsigned*)((const char*)(gbase) + (voff)[_i]), (PG8_LAS unsigned*)(lds + (bufoff) + ldsw + _i * 8192), 16, 0, 0); } while (0)
#define PG8_LDA(dst, b, h) do { _Pragma("unroll") for (int m = 0; m < 4; ++m) _Pragma("unroll") for (int k = 0; k < 2; ++k) dst[m][k] = *(const PG8_LAS bf16x8*)(lds + PG8_SA(b, h) + aoff + m * 2048 + k * 1024); } while (0)
#define PG8_LDB(dst, b, h) do { _Pragma("unroll") for (int n = 0; n < 2; ++n) _Pragma("unroll") for (int k = 0; k < 2; ++k) dst[n][k] = *(const PG8_LAS bf16x8*)(lds + PG8_SB(b, h) + boff + n * 2048 + k * 1024); } while (0)
#define PG8_MMA(ai, bj, At, Bt) do { __builtin_amdgcn_s_setprio(1); _Pragma("unroll") for (int m = 0; m < 4; ++m) _Pragma("unroll") for (int n = 0; n < 2; ++n) _Pragma("unroll") for (int k = 0; k < 2; ++k) \
        acc[ai][bj][m][n] = __builtin_amdgcn_mfma_f32_16x16x32_bf16(Bt[n][k], At[m][k], acc[ai][bj][m][n], 0, 0, 0); __builtin_amdgcn_s_setprio(0); } while (0)
#define PG8_WAIT_V(n) asm volatile("s_waitcnt vmcnt(" #n ")" ::: "memory")
#define PG8_WAIT_L(n) asm volatile("s_waitcnt lgkmcnt(" #n ")" ::: "memory")
#define PG8_BAR __builtin_amdgcn_s_barrier()
#define PG8_SCHED __builtin_amdgcn_sched_barrier(0)
    Unit cur, nxt; int ui = 0;
    if (!S.next(0, cur)) return;
    f32x4 acc[2][2][4][2];
#pragma unroll
    for (int a = 0; a < 2; ++a)
#pragma unroll
        for (int b = 0; b < 2; ++b)
#pragma unroll
            for (int m = 0; m < 4; ++m)
#pragma unroll
                for (int n = 0; n < 2; ++n) acc[a][b][m][n] = (f32x4){0.f, 0.f, 0.f, 0.f};
    bf16x8 At[4][2], B0[2][2], B1[2][2];
    const char* cA = (const char*)g.A + (size_t)cur.pm * tstep; const char* cB = (const char*)g.Bt + (size_t)cur.pn * tstep;
    S.a_ready(cur);
    if constexpr (SP2) {
        PG8_STAGE(PG8_SB(0, 0), cB, voffB); PG8_STAGE(PG8_SB(0, 1), cB + hstep, voffB); PG8_STAGE(PG8_SA(0, 0), cA, voffA); PG8_STAGE(PG8_SA(0, 1), cA + hstep, voffA);
        if (wr == 1) PG8_BAR;
        PG8_WAIT_V(2); PG8_BAR;
        PG8_STAGE(PG8_SB(1, 0), cB + kstep, voffB); PG8_STAGE(PG8_SA(1, 0), cA + kstep, voffA); PG8_STAGE(PG8_SB(1, 1), cB + hstep + kstep, voffB);
        PG8_WAIT_V(6); PG8_BAR;
    } else {
        PG8_STAGE(PG8_SB(0, 0), cB, voffB); PG8_STAGE(PG8_SA(0, 0), cA, voffA); PG8_STAGE(PG8_SB(0, 1), cB + hstep, voffB); PG8_STAGE(PG8_SA(0, 1), cA + hstep, voffA);
        if (wr == 1) PG8_BAR;
        PG8_WAIT_V(4); PG8_BAR;
        PG8_STAGE(PG8_SB(1, 0), cB + kstep, voffB); PG8_STAGE(PG8_SA(1, 0), cA + kstep, voffA); PG8_STAGE(PG8_SB(1, 1), cB + hstep + kstep, voffB);
        PG8_WAIT_V(6); PG8_BAR;
    }
    for (;;) {
        const bool has_next = S.next(ui + 1, nxt);
        const char* nA = has_next ? (const char*)g.A + (size_t)nxt.pm * tstep : cA; const char* nB = has_next ? (const char*)g.Bt + (size_t)nxt.pn * tstep : cB;
        for (int t = 0; t < nt; t += 2) {
            const bool last = (t == nt - 2);
            const char* a1 = cA + (size_t)(t + 1) * kstep;
            const char* a2 = last ? nA : cA + (size_t)(t + 2) * kstep; const char* b2 = last ? nB : cB + (size_t)(t + 2) * kstep;
            const char* a3 = a2 + kstep; const char* b3 = b2 + kstep;
            if (last && has_next) S.a_ready(nxt);
            if constexpr (SP2) {
            PG8_LDB(B0, 0, 0); PG8_LDB(B1, 0, 1); PG8_SCHED; PG8_LDA(At, 0, 0); PG8_STAGE(PG8_SA(1, 1), a1 + hstep, voffA);
            PG8_WAIT_V(8); PG8_WAIT_L(0); PG8_BAR; PG8_MMA(0, 0, At, B0); PG8_MMA(0, 1, At, B1); PG8_BAR; PG8_SCHED;
            PG8_LDA(At, 0, 1); PG8_STAGE(PG8_SB(0, 0), b2, voffB); PG8_STAGE(PG8_SB(0, 1), b2 + hstep, voffB); PG8_STAGE(PG8_SA(0, 0), a2, voffA);
            PG8_WAIT_V(8); PG8_WAIT_L(0); PG8_BAR; PG8_MMA(1, 0, At, B0); PG8_MMA(1, 1, At, B1); PG8_BAR; PG8_SCHED;
            PG8_LDB(B0, 1, 0); PG8_LDB(B1, 1, 1); PG8_SCHED; PG8_LDA(At, 1, 0); PG8_STAGE(PG8_SA(0, 1), a2 + hstep, voffA);
            PG8_WAIT_V(8); PG8_WAIT_L(0); PG8_BAR; PG8_MMA(0, 0, At, B0); PG8_MMA(0, 1, At, B1); PG8_BAR; PG8_SCHED;
            PG8_LDA(At, 1, 1); PG8_STAGE(PG8_SB(1, 0), b3, voffB); PG8_STAGE(PG8_SB(1, 1), b3 + hstep, voffB); PG8_STAGE(PG8_SA(1, 0), a3, voffA);
            PG8_WAIT_V(8); PG8_WAIT_L(0); PG8_BAR; PG8_MMA(1, 0, At, B0); PG8_MMA(1, 1, At, B1); PG8_BAR; PG8_SCHED;
            } else {
            PG8_LDB(B0, 0, 0); PG8_SCHED; PG8_LDA(At, 0, 0); PG8_STAGE(PG8_SA(1, 1), a1 + hstep, voffA);
            PG8_WAIT_L(8); PG8_BAR; PG8_WAIT_L(0); PG8_MMA(0, 0, At, B0); PG8_BAR; PG8_SCHED;
            PG8_LDB(B1, 0, 1); PG8_STAGE(PG8_SB(0, 0), b2, voffB);
            PG8_BAR; PG8_WAIT_L(0); PG8_MMA(0, 1, At, B1); PG8_BAR;
            PG8_LDA(At, 0, 1); PG8_STAGE(PG8_SA(0, 0), a2, voffA);
            PG8_BAR; PG8_WAIT_L(0); PG8_MMA(1, 0, At, B0); PG8_BAR; PG8_SCHED;
            PG8_STAGE(PG8_SB(0, 1), b2 + hstep, voffB);
            PG8_WAIT_V(6); PG8_BAR; PG8_MMA(1, 1, At, B1); PG8_BAR;
            PG8_LDB(B0, 1, 0); PG8_SCHED; PG8_LDA(At, 1, 0); PG8_STAGE(PG8_SA(0, 1), a2 + hstep, voffA);
            PG8_WAIT_L(8); PG8_BAR; PG8_WAIT_L(0); PG8_MMA(0, 0, At, B0); PG8_BAR; PG8_SCHED;
            PG8_LDB(B1, 1, 1); PG8_STAGE(PG8_SB(1, 0), b3, voffB);
            PG8_BAR; PG8_WAIT_L(0); PG8_MMA(0, 1, At, B1); PG8_BAR;
            PG8_LDA(At, 1, 1); PG8_STAGE(PG8_SA(1, 0), a3, voffA);
            PG8_BAR; PG8_WAIT_L(0); PG8_MMA(1, 0, At, B0); PG8_BAR; PG8_SCHED;
            PG8_STAGE(PG8_SB(1, 1), b3 + hstep, voffB);
            PG8_WAIT_V(6); PG8_BAR; PG8_MMA(1, 1, At, B1); PG8_BAR;
            }
        }
        if constexpr (ALIGN_EPI) { if (wr == 0) PG8_BAR; }
        if constexpr (!Epi::AFTER_DRAIN) { E(acc, cur, wr, wc, fr, fq); S.done(cur); }
        if (!has_next) break;
#pragma unroll
        for (int a = 0; a < 2; ++a)
#pragma unroll
            for (int b = 0; b < 2; ++b)
#pragma unroll
                for (int m = 0; m < 4; ++m)
#pragma unroll
                    for (int n = 0; n < 2; ++n) acc[a][b][m][n] = (f32x4){0.f, 0.f, 0.f, 0.f};
        cur = nxt; cA = nA; cB = nB; ++ui;
        if constexpr (ALIGN_EPI) { if (wr == 1) PG8_BAR; }
    }
    PG8_WAIT_V(0);
    if constexpr (!ALIGN_EPI) { if (wr == 0) PG8_BAR; }
    PG8_BAR;
    if constexpr (Epi::AFTER_DRAIN) { E.fused(acc, cur, wr, wc, fr, fq, lds, wid, lane); S.done(cur); }
#undef PG8_SA
#undef PG8_SB
#undef PG8_STAGE
#undef PG8_LDA
#undef PG8_LDB
#undef PG8_MMA
#undef PG8_WAIT_V
#undef PG8_WAIT_L
#undef PG8_BAR
#undef PG8_SCHED
}
}
constexpr int NWAVES = 8;
constexpr int DM = 2048, NBATCH = 4, SEQL = 4096, CTXL = 256, FF = 5504, FF2 = 11008;
constexpr int ML = NBATCH * SEQL, MC = NBATCH * CTXL, MT = ML + MC;
constexpr int ABN = 3584, NAN3 = 6144, MODW = 9 * DM;
constexpr float EPSN = 1e-6f;
constexpr float ATT_SCALE = 0.088388347648318440f;
#ifndef NPHASES_RUN
#define NPHASES_RUN 22
#endif
constexpr int N_PHASES = 22;

constexpr size_t MiB = 1u << 20;
constexpr size_t WS_CTL = 0, CTL_ZERO_BYTES = 1 * MiB;
constexpr size_t WS_MOD = 1 * MiB;
constexpr size_t WS_ROPE = 2 * MiB;
constexpr size_t WS_CARRY = 3 * MiB;
constexpr size_t WS_WLRU = 8 * MiB;
constexpr size_t WS_WFI = 16 * MiB;
constexpr size_t WS_WFO = 188 * MiB;
constexpr size_t WS_WABI = 274 * MiB, WS_WABO = 288 * MiB, WS_WNAI = 296 * MiB, WS_WNAO = 320 * MiB;
constexpr size_t WS_X = 328 * MiB;
constexpr size_t WS_H = 464 * MiB;
constexpr size_t WS_BIG = 532 * MiB;
constexpr size_t WS_END = 788 * MiB;
static_assert(WS_WFI + 4ull * FF2 * DM * 2 <= WS_WFO && WS_WFO + 4ull * DM * FF * 2 <= WS_WABI && WS_WABI + (size_t)ABN * DM * 2 <= WS_WABO && WS_WNAI + (size_t)NAN3 * DM * 2 <= WS_WNAO, "ws map (weights)");
static_assert(WS_X + (size_t)MT * DM * 4 <= WS_H && WS_H + (size_t)MT * DM * 2 <= WS_BIG && WS_BIG + (size_t)MT * NAN3 * 2 <= WS_END, "ws map (activations)");
constexpr int CW_BAR = 4096;

constexpr int RING_BYTES = 131072;
constexpr int LDSCTL_OFF = RING_BYTES, MISC_OFF = LDSCTL_OFF + 320;
constexpr int LDS_BYTES = 147456;

#define GAS __attribute__((address_space(1)))
#define LAS __attribute__((address_space(3)))
typedef unsigned short bf16;
typedef float f32x4 __attribute__((ext_vector_type(4)));
typedef float f32x2 __attribute__((ext_vector_type(2)));
typedef float f32x16 __attribute__((ext_vector_type(16)));
typedef short bf16x8 __attribute__((ext_vector_type(8)));
typedef short s16x4 __attribute__((ext_vector_type(4)));
typedef unsigned u32x4 __attribute__((ext_vector_type(4)));
typedef unsigned u32x2 __attribute__((ext_vector_type(2)));
#define RLX_AGENT __ATOMIC_RELAXED, __HIP_MEMORY_SCOPE_AGENT
#define LDS_WAIT() asm volatile("s_waitcnt lgkmcnt(0)" ::: "memory")
__device__ __forceinline__ unsigned cvtpk(float lo, float hi) { unsigned r; asm volatile("v_cvt_pk_bf16_f32 %0, %1, %2" : "=v"(r) : "v"(lo), "v"(hi)); return r; }
__device__ __forceinline__ float bflo(unsigned w) { return __uint_as_float(w << 16); }
__device__ __forceinline__ float bfhi(unsigned w) { return __uint_as_float(w & 0xffff0000u); }
__device__ __forceinline__ unsigned short f2bf(float f) { return (unsigned short)(cvtpk(f, f) & 0xffffu); }
__device__ __forceinline__ void unpack8(const u32x4 w, float (&x)[8]) { x[0] = bflo(w.x); x[1] = bfhi(w.x); x[2] = bflo(w.y); x[3] = bfhi(w.y); x[4] = bflo(w.z); x[5] = bfhi(w.z); x[6] = bflo(w.w); x[7] = bfhi(w.w); }
__device__ __forceinline__ u32x4 pack8(const float (&x)[8]) { u32x4 w; w.x = cvtpk(x[0], x[1]); w.y = cvtpk(x[2], x[3]); w.z = cvtpk(x[4], x[5]); w.w = cvtpk(x[6], x[7]); return w; }
__device__ __forceinline__ float sigmoid_f(float x) { return __builtin_amdgcn_rcpf(1.0f + __builtin_amdgcn_exp2f(-1.4426950408889634f * x)); }
template <int M> __device__ __forceinline__ float swz_xor(float v) { return __int_as_float(__builtin_amdgcn_ds_swizzle(__float_as_int(v), (M << 10) | 0x1f)); }
__device__ __forceinline__ float half_sum(float v) { auto rr = __builtin_amdgcn_permlane32_swap(__float_as_uint(v), __float_as_uint(v), false, false); return __uint_as_float(rr[0]) + __uint_as_float(rr[1]); }
__device__ __forceinline__ float wave_sum(float v) { v += swz_xor<1>(v); v += swz_xor<2>(v); v += swz_xor<4>(v); v += swz_xor<8>(v); v += swz_xor<16>(v); return half_sum(v); }
#define XB_TMO      128
#define XB_XCNT(j)  (256  + 64 * (j))
#define XB_XSUB(j)  (1280 + 64 * (j))
#define XB_XGEN(j)  (2304 + 64 * (j))
#define XB_TOP      3328
#define XB_TOPGEN   3392
#define XCD_BAR_WORDS 3456
#define XB_SPIN_CAP (1u << 18)

__device__ __forceinline__ unsigned xb_ld(unsigned* p)              { return __hip_atomic_load(p, __ATOMIC_RELAXED, __HIP_MEMORY_SCOPE_AGENT); }
__device__ __forceinline__ unsigned xb_add(unsigned* p, unsigned v) { return __hip_atomic_fetch_add(p, v, __ATOMIC_RELAXED, __HIP_MEMORY_SCOPE_AGENT); }
__device__ __forceinline__ unsigned xb_xcc_id() { return (unsigned)__builtin_amdgcn_s_getreg((3 << 11) | 20) & 0xFu; }
#define XB_SPIN(cond, bar) do { unsigned _sp = 0; while (cond) { __builtin_amdgcn_s_sleep(1); \
    if ((++_sp & 255u) == 0u) { if (xb_ld(&(bar)[XB_TMO])) break; if (_sp > XB_SPIN_CAP) { atomicAdd(&(bar)[XB_TMO], 1u); break; } } } } while (0)

struct XcdBarrier {
    unsigned* bar; unsigned x;
    volatile LAS unsigned* st;
};

__device__ __forceinline__ XcdBarrier xcd_barrier_post(unsigned* bar, volatile LAS unsigned* st) {
    XcdBarrier b; b.bar = bar; b.x = xb_xcc_id(); b.st = st;
    if (threadIdx.x == 0) (void)xb_add(&bar[XB_XCNT(b.x)], 1u);
    return b;
}
__device__ __forceinline__ void xcd_barrier_complete(unsigned* bar, unsigned x, unsigned& nloc, unsigned& nx) {
    const unsigned G = gridDim.x * gridDim.y * gridDim.z;
    unsigned sum, cnt, mine, sp = 0u;
    for (;;) {
        sum = 0u; cnt = 0u; mine = 0u;
#pragma unroll
        for (unsigned j = 0; j < 16; ++j) { const unsigned c = xb_ld(&bar[XB_XCNT(j)]); sum += c; cnt += (c > 0u) ? 1u : 0u; mine = (j == x) ? c : mine; }
        if (sum == G) break;
        __builtin_amdgcn_s_sleep(1);
        if ((++sp & 255u) == 0u) { if (xb_ld(&bar[XB_TMO])) break; if (sp > XB_SPIN_CAP) { atomicAdd(&bar[XB_TMO], 1u); break; } }
    }
    nloc = mine > 0u ? mine : 1u; nx = cnt > 0u ? cnt : 1u;
}

__device__ __forceinline__ void xcd_barrier(const XcdBarrier& b) {
    asm volatile("s_waitcnt vmcnt(0)" ::: "memory");
    __syncthreads();
    if (threadIdx.x == 0) {
        unsigned* bar = b.bar;
        __builtin_amdgcn_s_waitcnt(0);
        unsigned nloc = b.st[0], nx = b.st[1];
        if (nloc == 0u) { xcd_barrier_complete(bar, b.x, nloc, nx); b.st[0] = nloc; b.st[1] = nx; }
        const unsigned old = xb_add(&bar[XB_XSUB(b.x)], 1u);
        const unsigned gen = old / nloc;
        if (old + 1u == (gen + 1u) * nloc) {
            __builtin_amdgcn_fence(__ATOMIC_RELEASE, "agent");
            asm volatile("s_waitcnt vmcnt(0)" ::: "memory");
            const unsigned og = xb_add(&bar[XB_TOP], 1u);
            const unsigned tg = og / nx;
            if (og + 1u == (tg + 1u) * nx) xb_add(&bar[XB_TOPGEN], 1u);
            else XB_SPIN(xb_ld(&bar[XB_TOPGEN]) == tg, bar);
            __builtin_amdgcn_fence(__ATOMIC_ACQUIRE, "agent");
            xb_add(&bar[XB_XGEN(b.x)], 1u);
            asm volatile("s_waitcnt vmcnt(0)" ::: "memory");
        } else {
            XB_SPIN(xb_ld(&bar[XB_XGEN(b.x)]) == gen, bar);
            __builtin_amdgcn_fence(__ATOMIC_ACQUIRE, "agent");
            asm volatile("s_waitcnt vmcnt(0)" ::: "memory");
        }
    }
    __syncthreads();
}
struct Args { const float* in[26]; float* out; unsigned char* ws; int ph_lo, ph_hi; };
enum { IN_X = 0, IN_C, IN_CTX, IN_CCTX, IN_WMOD, IN_BMOD, IN_NORMG, IN_FWI, IN_FWO, IN_ABWI, IN_CONVW, IN_CONVB, IN_LWA, IN_LBA, IN_LWX, IN_LBX, IN_LAM,
       IN_AQN, IN_AKN, IN_SINK, IN_ABWO, IN_NAWI, IN_NAQN, IN_NAKN, IN_RPB, IN_NAWO };

__device__ __forceinline__ void p0_transpose_item(const float* W, int ldw, int K, bf16* WT, int dst_row0, int src_col0, int k0, LAS float* scr, int lane) {
#pragma unroll 8
    for (int i = 0; i < 32; ++i) { const int kk = 2 * i + (lane >> 5); scr[kk * 33 + (lane & 31)] = W[(size_t)(k0 + kk) * ldw + src_col0 + (lane & 31)]; }
    LDS_WAIT();
    const int c = lane & 7;
#pragma unroll
    for (int j = 0; j < 4; ++j) { const int n = (lane >> 3) + 8 * j; const LAS float* s = scr + (8 * c) * 33 + n;
        u32x4 o; o.x = cvtpk(s[0 * 33], s[1 * 33]); o.y = cvtpk(s[2 * 33], s[3 * 33]); o.z = cvtpk(s[4 * 33], s[5 * 33]); o.w = cvtpk(s[6 * 33], s[7 * 33]);
        *(u32x4*)(WT + (size_t)(dst_row0 + n) * K + k0 + 8 * c) = o; }
    LDS_WAIT();
}
__device__ __forceinline__ void p0_phase(const Args& a, LAS unsigned char* lds, int tid, int lane, int wave, int G) {
    asm volatile("" : "+v"(tid)); lane = tid & 63; wave = __builtin_amdgcn_readfirstlane(tid >> 6);
    unsigned char* ws = a.ws;
    LAS float* SC = (LAS float*)(lds + 69632);
    LAS float* RED = (LAS float*)(lds + 110592);
    for (int i = tid; i < 5 * DM; i += NWAVES * 64) { const float v = i < 4 * DM ? a.in[IN_C][i] : a.in[IN_CCTX][i - 4 * DM]; SC[i] = v * sigmoid_f(v); }
    __syncthreads();
    float* MOD = (float*)(ws + WS_MOD);
    for (int it = blockIdx.x; it < 2 * 576; it += G) {
        const int l = it / 576, col0 = (it % 576) * 32;
        const float* wp = a.in[IN_WMOD] + (size_t)l * DM * MODW + col0 + (lane & 7) * 4;
        f32x4 acc[5];
#pragma unroll
        for (int b = 0; b < 5; ++b) acc[b] = (f32x4){0.f, 0.f, 0.f, 0.f};
        const int kb = wave * 256 + (lane >> 3);
#pragma unroll 8
        for (int i = 0; i < 32; ++i) { const int k = kb + i * 8; const f32x4 wv = *(const f32x4*)(wp + (size_t)k * MODW);
#pragma unroll
            for (int b = 0; b < 5; ++b) acc[b] += SC[b * DM + k] * wv; }
#pragma unroll
        for (int b = 0; b < 5; ++b)
#pragma unroll
            for (int j = 0; j < 4; ++j) { float v = acc[b][j]; v += swz_xor<8>(v); v += swz_xor<16>(v); v = half_sum(v); acc[b][j] = v; }
        if (lane < 8) {
#pragma unroll
            for (int b = 0; b < 5; ++b) *(LAS f32x4*)(RED + (wave * 5 + b) * 32 + lane * 4) = acc[b]; }
        __syncthreads();
        if (tid < 160) { const int b = tid >> 5, cc = tid & 31; float s = a.in[IN_BMOD][l * MODW + col0 + cc];
#pragma unroll
            for (int w = 0; w < 8; ++w) s += RED[(w * 5 + b) * 32 + cc];
            MOD[(size_t)(l * 5 + b) * MODW + col0 + cc] = s; }
        __syncthreads();
    }
    if (blockIdx.x == 0) {
        f32x2* ROPE = (f32x2*)(ws + WS_ROPE);
        for (int i = tid; i < 64 * 32; i += NWAVES * 64) { const int pos = i >> 5, f = i & 31;
            const float inv = exp2f(-(float)f * (13.287712379549449f / 32.0f)); const float ang = (float)pos * inv;
            const double rev = (double)ang * 0.15915494309189535; const float fr = (float)(rev - __builtin_rint(rev));
            ROPE[i] = (f32x2){__builtin_amdgcn_cosf(fr), __builtin_amdgcn_sinf(fr)}; }
    }
    LAS float* scr = (LAS float*)(lds + wave * 8704);
    constexpr int I_FI = 32 * 344, I_FO = 86 * 64, I_ABI = 32 * 112, I_ABO = 32 * 64, I_NAI = 32 * 192, I_NAO = 32 * 64, I_LRU = 32 * 8;
    constexpr int NITEMS = 4 * I_FI + 4 * I_FO + I_ABI + I_ABO + I_NAI + I_NAO + I_LRU;
    const int gw = blockIdx.x * NWAVES + wave, NGW = G * NWAVES;
    for (int it = gw; it < NITEMS; it += NGW) {
        int r = it;
        if (r < 4 * I_FI) { const int m = r / I_FI, q = r % I_FI, kb = q / 344, nb = q % 344, R0 = nb * 32, tile = R0 >> 8, wi = R0 & 255;
            const int sc0 = wi < 128 ? tile * 128 + wi : FF + tile * 128 + (wi - 128);
            p0_transpose_item(a.in[IN_FWI] + (size_t)m * DM * FF2, FF2, DM, (bf16*)(ws + WS_WFI) + (size_t)m * FF2 * DM, R0, sc0, kb * 64, scr, lane); continue; }
        r -= 4 * I_FI;
        if (r < 4 * I_FO) { const int m = r / I_FO, q = r % I_FO, kb = q / 64, nb = q % 64;
            p0_transpose_item(a.in[IN_FWO] + (size_t)m * FF * DM, DM, FF, (bf16*)(ws + WS_WFO) + (size_t)m * DM * FF, nb * 32, nb * 32, kb * 64, scr, lane); continue; }
        r -= 4 * I_FO;
        if (r < I_ABI) { const int kb = r / 112, nb = r % 112; p0_transpose_item(a.in[IN_ABWI], ABN, DM, (bf16*)(ws + WS_WABI), nb * 32, nb * 32, kb * 64, scr, lane); continue; }
        r -= I_ABI;
        if (r < I_ABO) { const int kb = r / 64, nb = r % 64; p0_transpose_item(a.in[IN_ABWO], DM, DM, (bf16*)(ws + WS_WABO), nb * 32, nb * 32, kb * 64, scr, lane); continue; }
        r -= I_ABO;
        if (r < I_NAI) { const int kb = r / 192, nb = r % 192; p0_transpose_item(a.in[IN_NAWI], NAN3, DM, (bf16*)(ws + WS_WNAI), nb * 32, nb * 32, kb * 64, scr, lane); continue; }
        r -= I_NAI;
        if (r < I_NAO) { const int kb = r / 64, nb = r % 64; p0_transpose_item(a.in[IN_NAWO], DM, DM, (bf16*)(ws + WS_WNAO), nb * 32, nb * 32, kb * 64, scr, lane); continue; }
        r -= I_NAO;
        { const int mm = r >> 3, q = r & 7, which = mm >> 4, dir = (mm >> 3) & 1, blk = mm & 7, kb = q >> 2, nb = q & 3;
          const float* src = (which ? a.in[IN_LWX] : a.in[IN_LWA]) + (size_t)(dir * 8 + blk) * 128 * 128;
          bf16* dst = (bf16*)(ws + WS_WLRU) + (size_t)((dir * 2 + which) * 8 + blk) * 128 * 128;
          p0_transpose_item(src, 128, 128, dst, nb * 32, nb * 32, kb * 64, scr, lane); }
    }
}

__device__ __forceinline__ void norm_phase(const float* src_lat, const float* src_ctx, bf16* H, const float* g, const float* modl  ,
                                           int shift_idx, int scale_idx, int nrows, int tid, int G) {
    asm volatile("" : "+v"(tid)); const int lane = tid & 63, wave = __builtin_amdgcn_readfirstlane(tid >> 6), gw = blockIdx.x * NWAVES + wave, NGW = G * NWAVES;
    int cur = -1; f32x4 gs[8], sh[8];
    for (int row = gw; row < nrows; row += NGW) {
        const int slot = row < ML ? (row >> 12) : 4;
        if (slot != cur) { cur = slot;
            const f32x4* g4 = (const f32x4*)g + lane; const f32x4* sc4 = (const f32x4*)(modl + (size_t)(slot * 9 + scale_idx) * DM) + lane; const f32x4* sh4 = (const f32x4*)(modl + (size_t)(slot * 9 + shift_idx) * DM) + lane;
#pragma unroll
            for (int j = 0; j < 8; ++j) { gs[j] = g4[64 * j] * (sc4[64 * j] + 1.0f); sh[j] = sh4[64 * j]; } }
        const f32x4* xr = (const f32x4*)(row < ML ? src_lat + (size_t)row * DM : src_ctx + (size_t)(row - ML) * DM) + lane;
        f32x4 v[8]; float ss = 0.f;
#pragma unroll
        for (int j = 0; j < 8; ++j) { v[j] = xr[64 * j]; ss += (v[j].x * v[j].x + v[j].y * v[j].y) + (v[j].z * v[j].z + v[j].w * v[j].w); }
        const float rs = 1.0f / sqrtf(wave_sum(ss) * (1.0f / DM) + EPSN);
        u32x2* o8 = (u32x2*)(H + (size_t)row * DM) + lane;
#pragma unroll
        for (int j = 0; j < 8; ++j) { const f32x4 y = v[j] * rs * gs[j] + sh[j]; u32x2 w; w.x = cvtpk(y.x, y.y); w.y = cvtpk(y.z, y.w); o8[64 * j] = w; }
    }
}

template <bool FINAL>
__device__ __forceinline__ void lru_phase(const Args& a, LAS unsigned char* lds, int tid, int lane, int wave, int G) {
    asm volatile("" : "+v"(tid)); lane = tid & 63; wave = __builtin_amdgcn_readfirstlane(tid >> 6);
    unsigned char* ws = a.ws;
    const bf16* P = (const bf16*)(ws + WS_BIG); bf16* Y = (bf16*)(ws + WS_H); f32x2* CARRY = (f32x2*)(ws + WS_CARRY); const bf16* WL = (const bf16*)(ws + WS_WLRU);
    LAS unsigned char* U = lds;
    LAS float* ABa = (LAS float*)(lds + 17408); LAS float* ABb = ABa + 64 * 132;
    LAS float* HF = (LAS float*)(lds + 17408 + 2 * 64 * 132 * 4);
    const int l15 = lane & 15, l4 = lane >> 4;
    int cur_n = -1; bf16x8 wf[2][2][4]; float ba[2][4], bx[2][4], sp[2][4];
    const int c8 = (tid & 15) * 8;
    for (int u = blockIdx.x; u < 4 * 68 * 8; u += G) {
        const int n = u & 7, j = (u >> 3) % 68, b = u / 544;
        if (n != cur_n) { cur_n = n;
#pragma unroll
            for (int dir = 0; dir < 2; ++dir)
#pragma unroll
                for (int gt = 0; gt < 2; ++gt)
#pragma unroll
                    for (int ks = 0; ks < 4; ++ks) wf[dir][gt][ks] = *(const bf16x8*)(WL + ((size_t)(((dir * 2 + gt) * 8 + n) * 128 + 16 * wave + l15)) * 128 + 32 * ks + 8 * l4);
#pragma unroll
            for (int dir = 0; dir < 2; ++dir)
#pragma unroll
                for (int jj = 0; jj < 4; ++jj) { const int ch = dir * 1024 + 128 * n + 16 * wave + 4 * l4 + jj; ba[dir][jj] = a.in[IN_LBA][ch]; bx[dir][jj] = a.in[IN_LBX][ch];
                    const float lm = -a.in[IN_LAM][ch]; sp[dir][jj] = fmaxf(lm, 0.f) + log1pf(expf(-fabsf(lm))); }
        }
        const bool isctx = j < 4; const int Lseg = isctx ? CTXL : SEQL, t0 = isctx ? 64 * j : 64 * (j - 4);
        const size_t rowbase = isctx ? (size_t)(ML + CTXL * b) : (size_t)(SEQL * b);
        { float y[2][8]; const float* cwp = a.in[IN_CONVW] + 128 * n + c8; const float* cbp = a.in[IN_CONVB] + 128 * n + c8;
          { const f32x4 b0 = *(const f32x4*)cbp, b1 = *(const f32x4*)(cbp + 4);
#pragma unroll
            for (int e = 0; e < 4; ++e) { y[0][e] = b0[e]; y[0][4 + e] = b1[e]; y[1][e] = b0[e]; y[1][4 + e] = b1[e]; } }
#pragma unroll
          for (int k = 0; k < 4; ++k) { const f32x4 w0 = *(const f32x4*)(cwp + k * 1024), w1 = *(const f32x4*)(cwp + k * 1024 + 4);
#pragma unroll
            for (int pass = 0; pass < 2; ++pass) { const int ts = t0 + pass * 32 + (tid >> 4) + k - 2;
                if (ts >= 0 && ts < Lseg) { const u32x4 xv = *(const u32x4*)(P + (rowbase + ts) * ABN + 128 * n + c8); float x[8]; unpack8(xv, x);
#pragma unroll
                    for (int e = 0; e < 4; ++e) { y[pass][e] += x[e] * w0[e]; y[pass][4 + e] += x[4 + e] * w1[e]; } } } }
#pragma unroll
          for (int pass = 0; pass < 2; ++pass) *(LAS u32x4*)(U + (pass * 32 + (tid >> 4)) * 272 + c8 * 2) = pack8(y[pass]); }
        __syncthreads();
#pragma unroll
        for (int dir = 0; dir < 2; ++dir) {
            f32x4 acc[2][4];
#pragma unroll
            for (int mt = 0; mt < 4; ++mt) { bf16x8 uf[4];
#pragma unroll
                for (int ks = 0; ks < 4; ++ks) uf[ks] = *(const LAS bf16x8*)(U + (16 * mt + l15) * 272 + (32 * ks + 8 * l4) * 2);
#pragma unroll
                for (int gt = 0; gt < 2; ++gt) { f32x4 c4 = (f32x4){0.f, 0.f, 0.f, 0.f};
#pragma unroll
                    for (int ks = 0; ks < 4; ++ks) c4 = __builtin_amdgcn_mfma_f32_16x16x32_bf16(wf[dir][gt][ks], uf[ks], c4, 0, 0, 0);
                    acc[gt][mt] = c4; } }
            f32x4 av[4], bv[4];
#pragma unroll
            for (int mt = 0; mt < 4; ++mt) { const u32x2 uw = *(const LAS u32x2*)(U + (16 * mt + l15) * 272 + (16 * wave + 4 * l4) * 2);
                const float uu[4] = {bflo(uw.x), bfhi(uw.x), bflo(uw.y), bfhi(uw.y)};
#pragma unroll
                for (int jj = 0; jj < 4; ++jj) { const float r = sigmoid_f(acc[0][mt][jj] + ba[dir][jj]), ig = sigmoid_f(acc[1][mt][jj] + bx[dir][jj]);
                    const float la = -8.0f * r * sp[dir][jj]; const float aa = __builtin_amdgcn_exp2f(la * 1.4426950408889634f);
                    av[mt][jj] = aa; bv[mt][jj] = sqrtf(fmaxf(1.0f - aa * aa, 0.f)) * (ig * uu[jj]); } }
            if (dir == 1) __syncthreads();
#pragma unroll
            for (int mt = 0; mt < 4; ++mt) { *(LAS f32x4*)(ABa + (16 * mt + l15) * 132 + 16 * wave + 4 * l4) = av[mt]; *(LAS f32x4*)(ABb + (16 * mt + l15) * 132 + 16 * wave + 4 * l4) = bv[mt]; }
            __syncthreads();
            if (tid < 128) { const int c = tid; float h = 0.f, Ap = 1.f;
                f32x2* cr = CARRY + (size_t)((b * 2 + dir) * 68) * 1024 + 128 * n + c;
                if (FINAL) {
                    if (dir == 0) {
#pragma unroll 4
                        for (int i = 0; i < j; ++i) { const f32x2 ce = cr[(size_t)i * 1024]; h = ce.x * h + ce.y; } }
                    else if (j >= 4) {
#pragma unroll
                        for (int i = 3; i >= 0; --i) { const f32x2 ce = cr[(size_t)i * 1024]; h = ce.x * h + ce.y; }
#pragma unroll 4
                        for (int i = 67; i > j; --i) { const f32x2 ce = cr[(size_t)i * 1024]; h = ce.x * h + ce.y; } }
                    else { for (int i = 3; i > j; --i) { const f32x2 ce = cr[(size_t)i * 1024]; h = ce.x * h + ce.y; } }
                }
                if (dir == 0) {
#pragma unroll 8
                    for (int t = 0; t < 64; ++t) { const float aa = ABa[t * 132 + c], bb = ABb[t * 132 + c]; h = aa * h + bb; if (FINAL) HF[t * 128 + c] = h; else Ap *= aa; } }
                else {
#pragma unroll 8
                    for (int t = 63; t >= 0; --t) { const float aa = ABa[t * 132 + c], bb = ABb[t * 132 + c]; h = aa * h + bb; if (FINAL) HF[t * 128 + c] += h; else Ap *= aa; } }
                if (!FINAL) cr[(size_t)j * 1024] = (f32x2){Ap, h};
            }
        }
        __syncthreads();
        if (FINAL) {
            const int t = tid >> 3, c16 = (tid & 7) * 16; const size_t row = rowbase + t0 + t;
#pragma unroll
            for (int hh = 0; hh < 2; ++hh) { const u32x4 gw4 = *(const u32x4*)(P + row * ABN + 1024 + 128 * n + c16 + 8 * hh); float gl[8]; unpack8(gw4, gl); float o[8];
#pragma unroll
                for (int e = 0; e < 8; ++e) { const float x = gl[e]; const float z2 = 1.5957691216057308f * (x + 0.044715f * x * x * x); o[e] = HF[t * 128 + c16 + 8 * hh + e] * (x * sigmoid_f(z2)); }
                *(u32x4*)(Y + row * DM + 128 * n + c16 + 8 * hh) = pack8(o); }
        }
    }
    __syncthreads();
}

#define KSWZ(row, colB) ((row) * 256 + ((colB) ^ (((row) & 7) << 4)))
#define SBAR() __builtin_amdgcn_sched_barrier(0)
constexpr int AT_V = 0, AT_K = 16384, AT_WS = 32768, AT_RPB = 34816;
constexpr float AT_THR = 8.f;
__device__ __forceinline__ int crow(int r, int hi) { return (r & 3) + 8 * (r >> 2) + 4 * hi; }
__device__ __forceinline__ void partialSM(f32x16& p0, f32x16& p1, float& m_reg, float& mn, float& alpha) {
    constexpr float C = ATT_SCALE * 1.4426950408889634f;
    float pmax = p0[0];
#pragma unroll
    for (int r = 1; r < 16; ++r) pmax = fmaxf(pmax, p0[r]);
#pragma unroll
    for (int r = 0; r < 16; ++r) pmax = fmaxf(pmax, p1[r]);
    { auto rr = __builtin_amdgcn_permlane32_swap(__float_as_uint(pmax), __float_as_uint(pmax), false, false); pmax = fmaxf(__uint_as_float(rr[0]), __uint_as_float(rr[1])); }
    if (__builtin_expect(__all(pmax - m_reg <= AT_THR / ATT_SCALE), 1)) { mn = m_reg; alpha = 1.f; }
    else { mn = fmaxf(m_reg, pmax); alpha = __builtin_amdgcn_exp2f((m_reg - mn) * C); m_reg = mn; }
    const float mnC = -mn * C;
#pragma unroll
    for (int r = 0; r < 16; ++r) p0[r] = __builtin_amdgcn_exp2f(fmaf(p0[r], C, mnC));
#pragma unroll
    for (int r = 0; r < 16; ++r) p1[r] = __builtin_amdgcn_exp2f(fmaf(p1[r], C, mnC));
}
__device__ __forceinline__ void finishSM(const f32x16& p0, const f32x16& p1, float alpha, float& l_reg, bf16x8& pa0, bf16x8& pa1, bf16x8& pa2, bf16x8& pa3) {
    float ps = 0.f;
#pragma unroll
    for (int r = 0; r < 16; ++r) ps += p0[r];
#pragma unroll
    for (int r = 0; r < 16; ++r) ps += p1[r];
    { auto rr = __builtin_amdgcn_permlane32_swap(__float_as_uint(ps), __float_as_uint(ps), false, false); ps = __uint_as_float(rr[0]) + __uint_as_float(rr[1]); }
    l_reg = l_reg * alpha + ps;
#define PK4(P, BASE, OUT) do { unsigned a0 = cvtpk(P[BASE + 0], P[BASE + 1]), a1 = cvtpk(P[BASE + 2], P[BASE + 3]);   \
    unsigned b0 = cvtpk(P[BASE + 4], P[BASE + 5]), b1 = cvtpk(P[BASE + 6], P[BASE + 7]);                              \
    auto r0 = __builtin_amdgcn_permlane32_swap(a0, b0, false, false); auto r1 = __builtin_amdgcn_permlane32_swap(a1, b1, false, false); \
    u32x4 w = {r0[0], r1[0], r0[1], r1[1]}; OUT = __builtin_bit_cast(bf16x8, w); } while (0)
    PK4(p0, 0, pa0); PK4(p0, 8, pa1); PK4(p1, 0, pa2); PK4(p1, 8, pa3);
#undef PK4
}
__device__ __forceinline__ void qkt(f32x16& p0, f32x16& p1, const LAS unsigned char* Ks, const bf16x8* qr, int r32, int hi) {
#pragma unroll
    for (int r = 0; r < 16; ++r) { p0[r] = 0.f; p1[r] = 0.f; }
#pragma unroll
    for (int d0 = 0; d0 < 8; ++d0) { const int cb = (d0 * 16 + hi * 8) * 2;
        const bf16x8 b0 = *(const LAS bf16x8*)(Ks + KSWZ(r32, cb)); const bf16x8 b1 = *(const LAS bf16x8*)(Ks + KSWZ(32 + r32, cb));
        p0 = __builtin_amdgcn_mfma_f32_32x32x16_bf16(b0, qr[d0], p0, 0, 0, 0); p1 = __builtin_amdgcn_mfma_f32_32x32x16_bf16(b1, qr[d0], p1, 0, 0, 0); }
}
__device__ __forceinline__ int v_st(int k, int c) { const int kk = (k & ~0xC) | ((k & 4) << 1) | ((k & 8) >> 1); return ((kk >> 3) * 4 + (c >> 5)) * 512 + ((kk & 7) * 32 + (c & 31)) * 2; }
__device__ __forceinline__ int v_rd_base(int lane) { return ((lane & 3) << 3) | (((lane >> 2) & 3) << 6) | (((lane >> 4) & 1) << 5) | (((lane >> 5) & 1) << 8); }
constexpr int v_rd_off(int d0, int ks, int half) { return d0 * 512 + ks * 4096 + half * 2048; }
template <int OFF> __device__ __forceinline__ s16x4 tr_read(int vb) { s16x4 r; asm volatile("ds_read_b64_tr_b16 %0, %1 offset:%2" : "=&v"(r) : "v"(vb), "i"(OFF) : "memory"); return r; }
template <int D0> __device__ __forceinline__ void pv_one(f32x16& od, int vb, bf16x8 pa0, bf16x8 pa1, bf16x8 pa2, bf16x8 pa3) {
    const s16x4 l0 = tr_read<v_rd_off(D0, 0, 0)>(vb), h0 = tr_read<v_rd_off(D0, 0, 1)>(vb), l1 = tr_read<v_rd_off(D0, 1, 0)>(vb), h1 = tr_read<v_rd_off(D0, 1, 1)>(vb);
    const s16x4 l2 = tr_read<v_rd_off(D0, 2, 0)>(vb), h2 = tr_read<v_rd_off(D0, 2, 1)>(vb), l3 = tr_read<v_rd_off(D0, 3, 0)>(vb), h3 = tr_read<v_rd_off(D0, 3, 1)>(vb);
    asm volatile("s_waitcnt lgkmcnt(0)" ::: "memory"); SBAR();
#define PKV(L, H) (bf16x8){L[0], L[1], L[2], L[3], H[0], H[1], H[2], H[3]}
    od = __builtin_amdgcn_mfma_f32_32x32x16_bf16(pa0, PKV(l0, h0), od, 0, 0, 0);
    od = __builtin_amdgcn_mfma_f32_32x32x16_bf16(pa1, PKV(l1, h1), od, 0, 0, 0);
    od = __builtin_amdgcn_mfma_f32_32x32x16_bf16(pa2, PKV(l2, h2), od, 0, 0, 0);
    od = __builtin_amdgcn_mfma_f32_32x32x16_bf16(pa3, PKV(l3, h3), od, 0, 0, 0);
#undef PKV
}
__device__ __forceinline__ void sm_pv(f32x16& p0, f32x16& p1, f32x16 (&o)[4], float& m_reg, float& l_reg, int vb, LAS float* al_l, int r32, int hi) {
    float mn, alpha; partialSM(p0, p1, m_reg, mn, alpha);
    if (__any(alpha < 1.f)) { if (hi == 0) al_l[r32] = alpha; LDS_WAIT();
#pragma unroll
        for (int d = 0; d < 4; ++d)
#pragma unroll
            for (int r = 0; r < 16; ++r) o[d][r] *= al_l[crow(r, hi)];
        LDS_WAIT(); }
    bf16x8 pa0, pa1, pa2, pa3; finishSM(p0, p1, alpha, l_reg, pa0, pa1, pa2, pa3); SBAR();
    pv_one<0>(o[0], vb, pa0, pa1, pa2, pa3); pv_one<1>(o[1], vb, pa0, pa1, pa2, pa3); pv_one<2>(o[2], vb, pa0, pa1, pa2, pa3); pv_one<3>(o[3], vb, pa0, pa1, pa2, pa3);
}
__device__ __forceinline__ void stage_tile(const bf16* Kb, const bf16* Vb, int ld, const float (&kgv)[8], bool rope, int ktok0, const f32x2* ROPE, LAS unsigned char* lds, int tid) {
    const int sr = tid >> 4, sc = (tid & 15) * 8, l16 = tid & 15;
    u32x4 kw[2], vw[2];
#pragma unroll
    for (int hh = 0; hh < 2; ++hh) { const int rr = sr + 32 * hh; kw[hh] = *(const u32x4*)(Kb + (size_t)rr * ld + sc); vw[hh] = *(const u32x4*)(Vb + (size_t)rr * ld + sc); }
#pragma unroll
    for (int hh = 0; hh < 2; ++hh) { const int rr = sr + 32 * hh; float y[8]; unpack8(kw[hh], y); float ss = 0.f;
#pragma unroll
        for (int e = 0; e < 8; ++e) ss += y[e] * y[e];
        ss += swz_xor<1>(ss); ss += swz_xor<2>(ss); ss += swz_xor<4>(ss); ss += swz_xor<8>(ss);
        const float rs = 1.0f / sqrtf(ss * (1.0f / 128.0f) + EPSN);
#pragma unroll
        for (int e = 0; e < 8; ++e) y[e] *= rs * kgv[e];
        if (rope) { const int tok = ktok0 + rr; const int pos = (l16 < 8) ? (tok >> 6) : (tok & 63); const f32x2* rp = ROPE + pos * 32 + (l16 & 3) * 8; const float sg = (l16 & 4) ? 1.f : -1.f;
#pragma unroll
            for (int e = 0; e < 8; ++e) { const float pr = swz_xor<4>(y[e]); const f32x2 cs = rp[e]; y[e] = y[e] * cs.x + sg * pr * cs.y; } }
        *(LAS u32x4*)(lds + AT_K + KSWZ(rr, sc * 2)) = pack8(y);
        *(LAS u32x4*)(lds + AT_V + v_st(rr, sc)) = vw[hh]; }
}
__device__ __forceinline__ void load_q(bf16x8 (&qr)[8], const bf16* qp  , const float* qg, bool rope, int qtok, const f32x2* ROPE, int hi) {
    float x[8][8]; float ss = 0.f;
#pragma unroll
    for (int d0 = 0; d0 < 8; ++d0) { const u32x4 w = *(const u32x4*)(qp + d0 * 16 + hi * 8); unpack8(w, x[d0]);
#pragma unroll
        for (int e = 0; e < 8; ++e) ss += x[d0][e] * x[d0][e]; }
    ss = half_sum(ss);
    const float rs = 1.0f / sqrtf(ss * (1.0f / 128.0f) + EPSN);
#pragma unroll
    for (int d0 = 0; d0 < 8; ++d0) { const f32x4 g0 = *(const f32x4*)(qg + d0 * 16 + hi * 8), g1 = *(const f32x4*)(qg + d0 * 16 + hi * 8 + 4);
#pragma unroll
        for (int e = 0; e < 4; ++e) { x[d0][e] *= rs * g0[e]; x[d0][4 + e] *= rs * g1[e]; } }
    if (rope) {
#pragma unroll
        for (int half = 0; half < 2; ++half) { const int pos = half ? (qtok & 63) : (qtok >> 6);
#pragma unroll
            for (int dd = 0; dd < 2; ++dd) { const int d0 = half * 4 + dd; const f32x2* rp = ROPE + pos * 32 + dd * 16 + hi * 8;
#pragma unroll
                for (int e = 0; e < 8; ++e) { const f32x2 cs = rp[e]; const float x1 = x[d0][e], x2 = x[d0 + 2][e]; x[d0][e] = x1 * cs.x - x2 * cs.y; x[d0 + 2][e] = x2 * cs.x + x1 * cs.y; } } } }
#pragma unroll
    for (int d0 = 0; d0 < 8; ++d0) qr[d0] = __builtin_bit_cast(bf16x8, pack8(x[d0]));
}
__device__ __forceinline__ void store_o(const f32x16 (&o)[4], float l_reg, bf16* yb, LAS float* li_l, int r32, int hi) {
    if (hi == 0) li_l[r32] = l_reg; LDS_WAIT();
    asm volatile("" : "+v"(hi));
#pragma unroll
    for (int r = 0; r < 16; ++r) { const int orow = crow(r, hi); const float rl = __builtin_amdgcn_rcpf(li_l[orow]);
#pragma unroll
        for (int d0 = 0; d0 < 4; ++d0) yb[(size_t)orow * DM + d0 * 32 + r32] = f2bf(o[d0][r] * rl); }
    LDS_WAIT();
}

__device__ __forceinline__ void attn_ab_phase(const Args& a, LAS unsigned char* lds, int tid, int lane, int wave, int G) {
    asm volatile("" : "+v"(tid)); lane = tid & 63; wave = __builtin_amdgcn_readfirstlane(tid >> 6);
    unsigned char* ws = a.ws;
    const bf16* P = (const bf16*)(ws + WS_BIG); bf16* Y = (bf16*)(ws + WS_H); const f32x2* ROPE = (const f32x2*)(ws + WS_ROPE);
    const int r32 = lane & 31, hi = lane >> 5, sc = (tid & 15) * 8;
    float kgv[8];
#pragma unroll
    for (int e = 0; e < 8; ++e) kgv[e] = a.in[IN_AKN][sc + e];
    const int vb = (int)(uintptr_t)(lds + AT_V) + v_rd_base(lane);
    LAS float* wsf = (LAS float*)(lds + AT_WS) + wave * 64;
    for (int u = blockIdx.x; u < 544; u += G) {
        const bool lat = u < 512; const int v = u - 512;
        const int b = lat ? (u >> 7) : (v >> 3), kvh = lat ? ((u >> 6) & 1) : ((v >> 2) & 1), qb = lat ? (u & 63) : (v & 3);
        const int h = 4 * kvh + (wave >> 1), qi = 32 * (wave & 1) + r32, qtok = 64 * qb + qi;
        const size_t qrow = lat ? (size_t)(SEQL * b + qtok) : (size_t)(ML + CTXL * b + qtok);
        bf16x8 qr[8]; load_q(qr, P + qrow * ABN + 2048 + h * 128, a.in[IN_AQN], lat, qtok, ROPE, hi);
        float m_reg = a.in[IN_SINK][h] * (1.0f / ATT_SCALE), l_reg = 1.f;
        f32x16 o[4];
#pragma unroll
        for (int d = 0; d < 4; ++d)
#pragma unroll
            for (int r = 0; r < 16; ++r) o[d][r] = 0.f;
        const int ntl = lat ? 5 : 0;
        for (int ti = 0; ti < ntl + 4; ++ti) {
            const bool loc = ti < ntl; int ktok0; size_t krow0;
            if (loc) { ktok0 = 64 * qb - 128 + 64 * ti; if (ktok0 < 0 || ktok0 >= SEQL) continue; krow0 = (size_t)(SEQL * b + ktok0); }
            else { ktok0 = 64 * (ti - ntl); krow0 = (size_t)(ML + CTXL * b + ktok0); }
            __syncthreads();
            stage_tile(P + krow0 * ABN + 3072 + 128 * kvh, P + krow0 * ABN + 3328 + 128 * kvh, ABN, kgv, loc, ktok0, ROPE, lds, tid);
            __syncthreads();
            f32x16 p0, p1; qkt(p0, p1, lds + AT_K, qr, r32, hi);
            int qim = qi; asm volatile("" : "+v"(qim));
            if (loc && ti == 0) {
#pragma unroll
                for (int r = 0; r < 16; ++r) { const int kk = crow(r, hi); p0[r] = (kk >= qim) ? p0[r] : -INFINITY; p1[r] = (kk + 32 >= qim) ? p1[r] : -INFINITY; } }
            if (loc && ti == 4) {
#pragma unroll
                for (int r = 0; r < 16; ++r) { const int kk = crow(r, hi); p0[r] = (kk <= qim) ? p0[r] : -INFINITY; p1[r] = (kk + 32 <= qim) ? p1[r] : -INFINITY; } }
            sm_pv(p0, p1, o, m_reg, l_reg, vb, wsf + 32, r32, hi);
        }
        const size_t orow0 = qrow - r32;
        store_o(o, l_reg, Y + orow0 * DM + 1024 + h * 128, wsf, r32, hi);
    }
    __syncthreads();
}

__device__ __forceinline__ void attn_na_phase(const Args& a, LAS unsigned char* lds, int tid, int lane, int wave, int G) {
    asm volatile("" : "+v"(tid)); lane = tid & 63; wave = __builtin_amdgcn_readfirstlane(tid >> 6);
    unsigned char* ws = a.ws;
    const bf16* Q = (const bf16*)(ws + WS_BIG); bf16* Y = (bf16*)(ws + WS_H);
    const int r32 = lane & 31, hi = lane >> 5, sc = (tid & 15) * 8;
    float kgv[8];
#pragma unroll
    for (int e = 0; e < 8; ++e) kgv[e] = a.in[IN_NAKN][sc + e];
    const int vb = (int)(uintptr_t)(lds + AT_V) + v_rd_base(lane);
    LAS float* wsf = (LAS float*)(lds + AT_WS) + wave * 64;
    LAS float* RPB = (LAS float*)(lds + AT_RPB);
    for (int u = blockIdx.x; u < 1024; u += G) {
        const int b = u >> 8, h = (u >> 4) & 15, R = u & 15;
        const int r = 4 * R + (wave >> 1), qc = 32 * (wave & 1) + r32, qtok = 64 * r + qc;
        const size_t qrow = (size_t)(SEQL * b + qtok);
        bf16x8 qr[8]; load_q(qr, Q + qrow * NAN3 + h * 128, a.in[IN_NAQN], false, 0, nullptr, hi);
        __syncthreads();
        if (tid < 465) RPB[(tid / 31) * 128 + 48 + (tid % 31)] = a.in[IN_RPB][h * 465 + tid] * (1.0f / ATT_SCALE);
        float m_reg = -1e30f, l_reg = 0.f;
        f32x16 o[4];
#pragma unroll
        for (int d = 0; d < 4; ++d)
#pragma unroll
            for (int rr = 0; rr < 16; ++rr) o[d][rr] = 0.f;
        const int c0 = 4 * R - 4, c1 = 4 * R - 1;
        const int kr_lo = c0 < 0 ? 0 : (c0 > 56 ? 56 : c0), kr_hi = (c1 < 0 ? 0 : (c1 > 56 ? 56 : c1)) + 7;
        const int rsw = (r - 4) < 0 ? 0 : ((r - 4) > 56 ? 56 : (r - 4));
        const int wsq = (qc - 8) < 0 ? 0 : ((qc - 8) > 48 ? 48 : (qc - 8));
        const int nloc = kr_hi - kr_lo + 1;
        for (int ti = 0; ti < nloc + 4; ++ti) {
            const bool loc = ti < nloc; const int kr = kr_lo + ti;
            const size_t krow0 = loc ? (size_t)(SEQL * b + 64 * kr) : (size_t)(ML + CTXL * b + 64 * (ti - nloc));
            __syncthreads();
            stage_tile(Q + krow0 * NAN3 + 2048 + h * 128, Q + krow0 * NAN3 + 4096 + h * 128, NAN3, kgv, false, 0, nullptr, lds, tid);
            __syncthreads();
            if (!loc || (kr >= rsw && kr < rsw + 8)) {
                f32x16 p0, p1; qkt(p0, p1, lds + AT_K, qr, r32, hi);
                if (loc) { const LAS float* rp = RPB + (kr - r + 7) * 128 + 48 + (4 * hi - qc + 15); unsigned kb0 = (unsigned)(4 * hi - wsq); asm volatile("" : "+v"(kb0));
#pragma unroll
                    for (int rr = 0; rr < 16; ++rr) { const int kc = (rr & 3) + 8 * (rr >> 2);
                        p0[rr] = (kb0 + (unsigned)kc < 16u) ? p0[rr] + rp[kc] : -INFINITY; p1[rr] = (kb0 + (unsigned)(kc + 32) < 16u) ? p1[rr] + rp[kc + 32] : -INFINITY; } }
                sm_pv(p0, p1, o, m_reg, l_reg, vb, wsf + 32, r32, hi);
            }
        }
        const size_t orow0 = qrow - r32;
        store_o(o, l_reg, Y + orow0 * DM + h * 128, wsf, r32, hi);
    }
    __syncthreads();
}
__global__ void __launch_bounds__(NWAVES * 64, 2) fwd_kernel(Args a) {
    extern __shared__ __attribute__((aligned(16))) unsigned char lds_raw[];
    LAS unsigned char* lds = (LAS unsigned char*)lds_raw;
    const int tid = threadIdx.x, lane = tid & 63, wave = __builtin_amdgcn_readfirstlane(tid >> 6), G = gridDim.x;
    unsigned char* ws = a.ws;
    volatile LAS unsigned* MISC = (volatile LAS unsigned*)(lds + MISC_OFF);
    for (int u = tid; u < (LDS_BYTES - LDSCTL_OFF) / 4; u += NWAVES * 64) ((LAS unsigned*)(lds + LDSCTL_OFF))[u] = 0u;
    __syncthreads();
    XcdBarrier bar = xcd_barrier_post((unsigned*)(ws + WS_CTL) + CW_BAR, MISC + 8);
    const int lo = a.ph_lo, hi = a.ph_hi;
#define RUN(k) (lo <= (k) && (k) < hi)
#define SEAM(k) do { if (RUN(k) && RUN((k) + 1)) xcd_barrier(bar); } while (0)
    float* X = (float*)(ws + WS_X); bf16* H = (bf16*)(ws + WS_H); bf16* BIG = (bf16*)(ws + WS_BIG); const float* MOD = (const float*)(ws + WS_MOD);

    if (RUN(0)) p0_phase(a, lds, tid, lane, wave, G);
    SEAM(0);
    for (int s = 0; s < 4; ++s) {
        const int l = s >> 1, f = s & 1, pb = (s == 0) ? 1 : (s == 1) ? 9 : (s == 2) ? 12 : 19;
        const int Mrows = (s == 3) ? ML : MT;
        const float* modl = MOD + (size_t)l * 5 * MODW;
        const float* srcl = (s == 0) ? a.in[IN_X] : X; const float* srcc = (s == 0) ? a.in[IN_CTX] : X + (size_t)ML * DM;
        if (RUN(pb)) norm_phase(srcl, srcc, H, a.in[IN_NORMG] + (size_t)(l * 3 + 2 * f) * DM, modl, 6 * f, 6 * f + 1, Mrows, tid, G);
        SEAM(pb);
        if (RUN(pb + 1)) { pg8::Gemm g{H, (const bf16*)(ws + WS_WFI) + (size_t)s * FF2 * DM, Mrows, FF2, DM}; pg8::StaticOrder S; S.init(Mrows, FF2, G, (int)blockIdx.x);
            pg8::EpiSwiGLU E{BIG, FF}; pg8::gemm_phase<pg8::EpiSwiGLU, pg8::StaticOrder, true, true>(lds, g, S, E); }
        SEAM(pb + 1);
        if (RUN(pb + 2)) { pg8::Gemm g{BIG, (const bf16*)(ws + WS_WFO) + (size_t)s * DM * FF, Mrows, DM, FF}; pg8::StaticOrder S; S.init(Mrows, DM, G, (int)blockIdx.x);
            pg8::EpiResid E{srcl, srcc, (s == 3) ? a.out : X, X + (size_t)ML * DM, modl + (size_t)(6 * f + 2) * DM, 0.5f};
            pg8::gemm_phase<pg8::EpiResid, pg8::StaticOrder, true, true>(lds, g, S, E); }
        SEAM(pb + 2);
        if (s == 0) {
            if (RUN(4)) norm_phase(X, X + (size_t)ML * DM, H, a.in[IN_NORMG] + (size_t)(0 * 3 + 1) * DM, modl, 3, 4, MT, tid, G);
            SEAM(4);
            if (RUN(5)) { pg8::Gemm g{H, (const bf16*)(ws + WS_WABI), MT, ABN, DM}; pg8::StaticOrder S; S.init(MT, ABN, G, (int)blockIdx.x);
                pg8::EpiBf16 E{BIG, ABN}; pg8::gemm_phase<pg8::EpiBf16, pg8::StaticOrder, true, true>(lds, g, S, E); }
            SEAM(5);
            if (RUN(6)) lru_phase<false>(a, lds, tid, lane, wave, G);
            SEAM(6);
            if (RUN(7)) { attn_ab_phase(a, lds, tid, lane, wave, G); lru_phase<true>(a, lds, tid, lane, wave, G); }
            SEAM(7);
            if (RUN(8)) { pg8::Gemm g{H, (const bf16*)(ws + WS_WABO), MT, DM, DM}; pg8::StaticOrder S; S.init(MT, DM, G, (int)blockIdx.x);
                pg8::EpiResid E{X, X + (size_t)ML * DM, X, X + (size_t)ML * DM, modl + (size_t)5 * DM, 1.0f};
                pg8::gemm_phase<pg8::EpiResid, pg8::StaticOrder, true, true>(lds, g, S, E); }
            SEAM(8);
        }
        if (s == 2) {
            if (RUN(15)) norm_phase(X, X + (size_t)ML * DM, H, a.in[IN_NORMG] + (size_t)(1 * 3 + 1) * DM, modl, 3, 4, MT, tid, G);
            SEAM(15);
            if (RUN(16)) {
                { pg8::Gemm g{H, (const bf16*)(ws + WS_WNAI), ML, NAN3, DM}; pg8::StaticOrder S; S.init(ML, NAN3, G, (int)blockIdx.x);
                  pg8::EpiBf16 E{BIG, NAN3}; pg8::gemm_phase<pg8::EpiBf16, pg8::StaticOrder, true, true>(lds, g, S, E); }
                { pg8::Gemm g{H + (size_t)ML * DM, (const bf16*)(ws + WS_WNAI) + (size_t)DM * DM, MC, 2 * DM, DM}; pg8::StaticOrder S; S.init(MC, 2 * DM, G, (int)blockIdx.x);
                  pg8::EpiBf16 E{BIG + (size_t)ML * NAN3 + DM, NAN3}; pg8::gemm_phase<pg8::EpiBf16, pg8::StaticOrder, true, true>(lds, g, S, E); }
            }
            SEAM(16);
            if (RUN(17)) attn_na_phase(a, lds, tid, lane, wave, G);
            SEAM(17);
            if (RUN(18)) { pg8::Gemm g{H, (const bf16*)(ws + WS_WNAO), ML, DM, DM}; pg8::StaticOrder S; S.init(ML, DM, G, (int)blockIdx.x);
                pg8::EpiResid E{X, X + (size_t)ML * DM, X, X + (size_t)ML * DM, modl + (size_t)5 * DM, 1.0f};
                pg8::gemm_phase<pg8::EpiResid, pg8::StaticOrder, true, true>(lds, g, S, E); }
            SEAM(18);
        }
    }
    if (hi < N_PHASES) {
        xcd_barrier(bar);
        const f32x4* src = (const f32x4*)(hi > 3 ? (const float*)X : a.in[IN_X]); f32x4* dst = (f32x4*)a.out;
        for (size_t i = (size_t)blockIdx.x * (NWAVES * 64) + tid; i < (size_t)ML * DM / 4; i += (size_t)G * (NWAVES * 64)) dst[i] = src[i];
    }
#undef RUN
#undef SEAM
}

extern "C" void kernel_launch(void* const* d_in, const int* in_sizes, int n_in, void* d_out, int out_size, void* d_ws, size_t ws_size, hipStream_t stream) {
    static int grid = 0;
    if (grid == 0) {
        if (n_in != 26 || in_sizes[0] != ML * DM || out_size != ML * DM || ws_size < WS_END) { fprintf(stderr, "kernel_launch: shape mismatch: n_in %d in0 %d out %d ws %zu (need %zu)\n", n_in, n_in > 0 ? in_sizes[0] : -1, out_size, ws_size, (size_t)WS_END); grid = -1; return; }
        int dev = 0, cus = 0, per_cu = 0;
        if (hipGetDevice(&dev) != hipSuccess || hipDeviceGetAttribute(&cus, hipDeviceAttributeMultiprocessorCount, dev) != hipSuccess) { grid = -1; return; }
        if (hipFuncSetAttribute((const void*)fwd_kernel, hipFuncAttributeMaxDynamicSharedMemorySize, LDS_BYTES) != hipSuccess) { fprintf(stderr, "kernel_launch: hipFuncSetAttribute failed\n"); grid = -1; return; }
        if (hipOccupancyMaxActiveBlocksPerMultiprocessor(&per_cu, (const void*)fwd_kernel, NWAVES * 64, LDS_BYTES) != hipSuccess || per_cu < 1) fprintf(stderr, "kernel_launch: occupancy query says %d\n", per_cu);
        (void)hipGetLastError();
        grid = cus;
    }
    if (grid < 0) return;
    if (hipMemsetAsync((char*)d_ws + WS_CTL, 0, CTL_ZERO_BYTES, stream) != hipSuccess) return;
    Args a{};
    for (int i = 0; i < 26; ++i) a.in[i] = (const float*)d_in[i];
    a.out = (float*)d_out; a.ws = (unsigned char*)d_ws; a.ph_lo = 0; a.ph_hi = NPHASES_RUN;
    hipLaunchKernelGGL(fwd_kernel, dim3(grid), dim3(NWAVES * 64), LDS_BYTES, stream, a);
    const hipError_t le = hipPeekAtLastError();
    if (le != hipSuccess) fprintf(stderr, "kernel_launch: launch failed: %s\n", hipGetErrorName(le));
}
```

```cpp
#include <hip/hip_runtime.h>
#include <cstdio>
#include <cstdint>
#ifndef PG8_WGM
#define PG8_WGM 8
#endif
#ifndef PG8_STAGGER
#define PG8_STAGGER 1
#endif
namespace pg8 {
#define PG8_LAS __attribute__((address_space(3)))
typedef unsigned short bf16_t;
typedef short bf16x8 __attribute__((ext_vector_type(8)));
typedef float f32x4 __attribute__((ext_vector_type(4)));
typedef unsigned u32x4 __attribute__((ext_vector_type(4)));
typedef int i32x4 __attribute__((ext_vector_type(4)));
__device__ __forceinline__ f32x4 mma16(bf16x8 a, bf16x8 b, f32x4 c) { return __builtin_amdgcn_mfma_f32_16x16x32_bf16(a, b, c, 0, 0, 0); }
__device__ __forceinline__ i32x4 mma16(bf16x8 a, bf16x8 b, i32x4 c) { return __builtin_amdgcn_mfma_i32_16x16x64_i8(__builtin_bit_cast(i32x4, a), __builtin_bit_cast(i32x4, b), c, 0, 0, 0); }
constexpr int BM = 256, BK = 64, HALF = 128, HTB = HALF * BK * 2  , STAGE_BYTES = 8 * HTB, NXCD = 8, WGM = PG8_WGM;

__host__ __device__ __forceinline__ int lds_byte(int r, int c) { const int st = (r >> 4) * 2 + (c >> 5), rr = r & 15, cc = c & 31, ob = rr * 64 + cc * 2; return st * 1024 + (ob ^ (((ob >> 9) & 1) << 5)); }
__host__ __device__ __forceinline__ void stage_rc(int b, int& R, int& C) { const int st = b / 1024, sb = b % 1024, swz = sb ^ (((sb >> 9) & 1) << 5); R = (st >> 1) * 16 + swz / 64; C = (st & 1) * 32 + (swz % 64) / 2; }
__host__ __device__ __forceinline__ int perm32(int rho) { const int n = rho >> 4, i = rho & 15; return 8 * (i >> 2) + 4 * n + (i & 3); }

struct Unit { int pm, pn, kt0, nkt, piece; };
struct Gemm { const bf16_t* A; const bf16_t* Bt; int M, N, K; size_t pitchA, kstepA, pitchB, kstepB; };
__host__ __device__ __forceinline__ Gemm gemm_rr(const bf16_t* A, const bf16_t* Bt, int M, int N, int K) { return Gemm{A, Bt, M, N, K, (size_t)K * 2, 128, (size_t)K * 2, 128}; }
__host__ __device__ __forceinline__ Gemm gemm_tt(const bf16_t* A, size_t rowsA, const bf16_t* Bt, size_t rowsB, int M, int N, int K) { return Gemm{A, Bt, M, N, K, 128, rowsA * 128, 128, rowsB * 128}; }

struct StaticOrder {
    int nM, nN, nwg, G, c, nkt, wgm;
    __host__ __device__ void init(int M, int N, int G_, int c_, int K, int wgm_ = WGM) { nM = M / BM; nN = N / BM; nwg = nM * nN; G = G_; c = c_; nkt = K / BK; wgm = wgm_; }
    __host__ __device__ bool next(int i, Unit& u) const {
        const long L = (long)i * G + c; if (L >= nwg) return false;
        int wgid = (int)L; { const int q = nwg / NXCD, r = nwg % NXCD, xcd = wgid % NXCD, off = wgid / NXCD; wgid = (xcd < r ? xcd * (q + 1) : r * (q + 1) + (xcd - r) * q) + off; }
        const int nig = wgm * nN, gid = wgid / nig, fm = gid * wgm, gsz = (nM - fm) < wgm ? (nM - fm) : wgm;
        u.pm = fm + ((wgid % nig) % gsz); u.pn = (wgid % nig) / gsz; u.kt0 = 0; u.nkt = nkt; u.piece = -1; return true;
    }
    __device__ __forceinline__ void a_ready(const Unit&) const {}
    __device__ __forceinline__ void done(const Unit&) const {}
};
struct CtxSplitOrder {
    StaticOrder lat; int nN, nkb, nlat, npf;
    __host__ __device__ void init(int N, int G_, int c_, int K, bool with_ctx, int wgm_ = WGM) { lat.init(64 * BM, N, G_, c_, K, wgm_); nN = with_ctx ? N / BM : 0; nkb = K / 128; nlat = (lat.nwg - c_ + G_ - 1) / G_; if (nlat < 0) nlat = 0;
        const int tot = 4 * nN * 8; npf = (PG8_STAGGER && (c_ & 4) && c_ < tot && c_ + G_ >= tot) ? 1 : 0; }
    __host__ __device__ bool next(int i, Unit& u) const {
        const int nl = nlat, tot = 4 * nN * 8;
        int ii = i; if (npf) { if (i > nl) return false; ii = (i == 0) ? nl : i - 1; }
        if (ii < nl) return lat.next(ii, u);
        const int ip = ii - nl;
        const int q = ip * lat.G + lat.c; if (q >= tot) return false;
        const int cu = q >> 3, p = q & 7, k0 = (p * nkb) >> 3, k1 = ((p + 1) * nkb) >> 3;
        u.pm = 64 + cu / nN; u.pn = cu - (cu / nN) * nN; u.kt0 = 2 * k0; u.nkt = 2 * (k1 - k0); u.piece = p; return true;
    }
    __device__ __forceinline__ void a_ready(const Unit&) const {}
    __device__ __forceinline__ void done(const Unit&) const {}
};
__device__ __forceinline__ unsigned cvt_pk_bf16(float lo, float hi) { unsigned r; asm volatile("v_cvt_pk_bf16_f32 %0, %1, %2" : "=v"(r) : "v"(lo), "v"(hi)); return r; }
typedef float f32x2 __attribute__((ext_vector_type(2)));
typedef unsigned u32x2p __attribute__((ext_vector_type(2)));
__device__ __forceinline__ float silu_f(float x) { return x * __builtin_amdgcn_rcpf(1.0f + __builtin_amdgcn_exp2f(-1.4426950408889634f * x)); }
struct EpiBf16 {
    static constexpr bool PERM = true, AFTER_DRAIN = false, L2PF = false; typedef f32x4 acc_t;
    bf16_t* O; int ldc;
    struct Pre {}; __device__ __forceinline__ void prefetch(Pre&, const Unit&, int, int, int, int) const {}
    __device__ __forceinline__ void operator()(const f32x4 (&acc)[2][2][4][2], const Unit& u, int wr, int wc, int fr, int fq, const Pre&) const {
        const int row0 = u.pm * BM + wr * 64 + fr, col0 = u.pn * BM + wc * 32 + 8 * fq;
#pragma unroll
        for (int ai = 0; ai < 2; ++ai)
#pragma unroll
            for (int m = 0; m < 4; ++m) { bf16_t* rowp = O + (size_t)(row0 + ai * HALF + m * 16) * ldc + col0;
#pragma unroll
                for (int bj = 0; bj < 2; ++bj) { const f32x4 v0 = acc[ai][bj][m][0], v1 = acc[ai][bj][m][1];
                    u32x4 w; w.x = cvt_pk_bf16(v0[0], v0[1]); w.y = cvt_pk_bf16(v0[2], v0[3]); w.z = cvt_pk_bf16(v1[0], v1[1]); w.w = cvt_pk_bf16(v1[2], v1[3]);
                    *(u32x4*)(rowp + bj * HALF) = w; } }
    }
};
struct EpiSwiGLU {
    static constexpr bool PERM = true, AFTER_DRAIN = false, L2PF = false; typedef f32x4 acc_t;
    bf16_t* O; int rows;
    struct Pre {}; __device__ __forceinline__ void prefetch(Pre&, const Unit&, int, int, int, int) const {}
    __device__ __forceinline__ void operator()(const f32x4 (&acc)[2][2][4][2], const Unit& u, int wr, int wc, int fr, int fq, const Pre&) const {
        const int row0 = u.pm * BM + wr * 64 + fr, col0 = u.pn * HALF + wc * 32 + 8 * fq;
        bf16_t* base = O + (size_t)(col0 >> 6) * rows * 64 + (col0 & 63);
#pragma unroll
        for (int ai = 0; ai < 2; ++ai)
#pragma unroll
            for (int m = 0; m < 4; ++m) { bf16_t* rowp = base + (size_t)(row0 + ai * HALF + m * 16) * 64;
                const f32x4 g0 = acc[ai][0][m][0], g1 = acc[ai][0][m][1], u0 = acc[ai][1][m][0], u1 = acc[ai][1][m][1];
                u32x4 w; w.x = cvt_pk_bf16(silu_f(g0[0]) * u0[0], silu_f(g0[1]) * u0[1]); w.y = cvt_pk_bf16(silu_f(g0[2]) * u0[2], silu_f(g0[3]) * u0[3]);
                w.z = cvt_pk_bf16(silu_f(g1[0]) * u1[0], silu_f(g1[1]) * u1[1]); w.w = cvt_pk_bf16(silu_f(g1[2]) * u1[2], silu_f(g1[3]) * u1[3]);
                *(u32x4*)rowp = w; }
    }
};
__device__ __forceinline__ void xl4(u32x2p (&x)[2][2], const bf16_t* p) {
    asm volatile("global_load_dwordx2 %0, %4, off\n\tglobal_load_dwordx2 %1, %4, off offset:32\n\tglobal_load_dwordx2 %2, %4, off offset:256\n\tglobal_load_dwordx2 %3, %4, off offset:288"
                 : "=&v"(x[0][0]), "=&v"(x[0][1]), "=&v"(x[1][0]), "=&v"(x[1][1]) : "v"(p) : "memory"); }
template <int N> __device__ __forceinline__ void xw4(u32x2p (&x)[2][2]) { asm volatile("s_waitcnt vmcnt(%4)" : "+v"(x[0][0]), "+v"(x[0][1]), "+v"(x[1][0]), "+v"(x[1][1]) : "n"(N) : "memory"); }
struct EpiResid {
    static constexpr bool PERM = false, AFTER_DRAIN = false, L2PF = true; typedef f32x4 acc_t;
    const bf16_t* src_lat; const bf16_t* src_ctx; bf16_t* dst_lat; bf16_t* dst_ctx; const float* gate; float gs; bf16_t* part;
    struct Pre {}; __device__ __forceinline__ void prefetch(Pre&, const Unit&, int, int, int, int) const {}
    __device__ __forceinline__ void l2pf(const Unit& u, int wid, int lane, PG8_LAS unsigned char* dummy) const {
        if (u.piece >= 0) return;
        const bf16_t* base = u.pm < 64 ? src_lat + (size_t)u.pm * BM * 2048 : src_ctx + (size_t)(u.pm - 64) * BM * 2048;
#pragma unroll
        for (int k = 0; k < 2; ++k) { const int li = wid * 128 + k * 64 + lane, row = li >> 2, seg = li & 3;
            __builtin_amdgcn_global_load_lds((const unsigned*)(base + (size_t)row * 2048 + u.pn * BM + seg * 64), (PG8_LAS unsigned*)(dummy + wid * 512 + k * 256), 4, 0, 0); }
    }
    __device__ __forceinline__ void operator()(const f32x4 (&acc)[2][2][4][2], const Unit& u, int wr, int wc, int fr, int fq, const Pre&) const {
        const int rl = wr * 64 + fr, col0 = u.pn * BM + wc * 32 + 4 * fq;
        if (u.piece >= 0) { bf16_t* pb = part + ((size_t)u.piece * 1024 + (size_t)(u.pm - 64) * BM + rl) * 2048 + col0;
#pragma unroll
            for (int ai = 0; ai < 2; ++ai)
#pragma unroll
                for (int m = 0; m < 4; ++m)
#pragma unroll
                    for (int bj = 0; bj < 2; ++bj)
#pragma unroll
                        for (int n = 0; n < 2; ++n) { const f32x4 v = acc[ai][bj][m][n]; u32x2p w; w.x = cvt_pk_bf16(v[0], v[1]); w.y = cvt_pk_bf16(v[2], v[3]); *(u32x2p*)(pb + (size_t)(ai * HALF + m * 16) * 2048 + bj * HALF + n * 16) = w; }
            return; }
        const bool lat = u.pm < 64; const int slot = lat ? (u.pm >> 4) : 4;
        const float* gp = gate + (size_t)slot * (9 * 2048) + col0;
        const bf16_t* sb = (lat ? src_lat + (size_t)u.pm * BM * 2048 : src_ctx + (size_t)(u.pm - 64) * BM * 2048) + (size_t)rl * 2048 + col0;
        bf16_t* db = (lat ? dst_lat + (size_t)u.pm * BM * 2048 : dst_ctx + (size_t)(u.pm - 64) * BM * 2048) + (size_t)rl * 2048 + col0;
        f32x4 gv[2][2];
#pragma unroll
        for (int bj = 0; bj < 2; ++bj)
#pragma unroll
            for (int n = 0; n < 2; ++n) gv[bj][n] = *(const f32x4*)(gp + bj * HALF + n * 16) * gs;
        asm volatile("s_waitcnt vmcnt(0)" ::: "memory");
        u32x2p xr[2][2]; xl4(xr, sb);
#pragma unroll
        for (int g = 0; g < 8; ++g) { const int ai = g >> 2, m = g & 3; const size_t off = (size_t)(ai * HALF + m * 16) * 2048;
            if (g == 0) xw4<0>(xr); else xw4<4>(xr);
            f32x4 yy[2][2];
#pragma unroll
            for (int bj = 0; bj < 2; ++bj)
#pragma unroll
                for (int n = 0; n < 2; ++n) { const u32x2p xw = xr[bj][n];
                    const f32x4 x = (f32x4){__uint_as_float(xw.x << 16), __uint_as_float(xw.x & 0xffff0000u), __uint_as_float(xw.y << 16), __uint_as_float(xw.y & 0xffff0000u)};
                    yy[bj][n] = x + gv[bj][n] * acc[ai][bj][m][n]; }
            __builtin_amdgcn_sched_barrier(0);
            if (g < 7) xl4(xr, sb + (size_t)(((g + 1) >> 2) * HALF + ((g + 1) & 3) * 16) * 2048);
            __builtin_amdgcn_sched_barrier(0);
#pragma unroll
            for (int bj = 0; bj < 2; ++bj)
#pragma unroll
                for (int n = 0; n < 2; ++n) { u32x2p w; w.x = cvt_pk_bf16(yy[bj][n][0], yy[bj][n][1]); w.y = cvt_pk_bf16(yy[bj][n][2], yy[bj][n][3]); *(u32x2p*)(db + off + bj * HALF + n * 16) = w; }
            __builtin_amdgcn_sched_barrier(0); }
    }
};
struct EpiDelta {
    static constexpr bool PERM = true, AFTER_DRAIN = false, L2PF = false; typedef f32x4 acc_t;
    bf16_t* D; float* part;
    struct Pre {}; __device__ __forceinline__ void prefetch(Pre&, const Unit&, int, int, int, int) const {}
    __device__ __forceinline__ void operator()(const f32x4 (&acc)[2][2][4][2], const Unit& u, int wr, int wc, int fr, int fq, const Pre&) const {
        const int rl = wr * 64 + fr, col0 = u.pn * BM + wc * 32 + 8 * fq;
        if (u.piece >= 0) { float* pb = part + ((size_t)u.piece * 1024 + (size_t)(u.pm - 64) * BM + rl) * 2048 + col0;
#pragma unroll
            for (int ai = 0; ai < 2; ++ai)
#pragma unroll
                for (int m = 0; m < 4; ++m)
#pragma unroll
                    for (int bj = 0; bj < 2; ++bj)
#pragma unroll
                        for (int n = 0; n < 2; ++n) *(f32x4*)(pb + (size_t)(ai * HALF + m * 16) * 2048 + bj * HALF + 4 * n) = acc[ai][bj][m][n];
            return; }
        bf16_t* db = D + ((size_t)u.pm * BM + rl) * 2048 + col0;
#pragma unroll
        for (int ai = 0; ai < 2; ++ai)
#pragma unroll
            for (int m = 0; m < 4; ++m)
#pragma unroll
                for (int bj = 0; bj < 2; ++bj) { const f32x4 v0 = acc[ai][bj][m][0], v1 = acc[ai][bj][m][1];
                    u32x4 w; w.x = cvt_pk_bf16(v0[0], v0[1]); w.y = cvt_pk_bf16(v0[2], v0[3]); w.z = cvt_pk_bf16(v1[0], v1[1]); w.w = cvt_pk_bf16(v1[2], v1[3]);
                    *(u32x4*)(db + (size_t)(ai * HALF + m * 16) * 2048 + bj * HALF) = w; }
    }
};
struct EpiSwiGLUI8 {
    static constexpr bool PERM = true, AFTER_DRAIN = false, L2PF = false; typedef i32x4 acc_t;
    bf16_t* O; int rows; const float* rowscale; const float* wmax; int upoff; PG8_LAS unsigned char* scr;
    struct Pre {};
    __device__ __forceinline__ void prefetch(Pre&, const Unit& u, int wr, int wc, int fr, int fq) const {
        const int lane = fr + 16 * fq; PG8_LAS unsigned char* t = scr + (wr * 4 + wc) * 768;
        const float* g0 = wmax + ((lane & 32) ? upoff : 0) + u.pn * HALF + wc * 32 + (lane & 31); const float* r0 = rowscale + u.pm * BM + wr * 64 + lane;
        asm volatile("s_waitcnt lgkmcnt(0)" ::: "memory");
        __builtin_amdgcn_global_load_lds((const unsigned*)g0, (PG8_LAS unsigned*)t, 4, 0, 0);
        __builtin_amdgcn_global_load_lds((const unsigned*)r0, (PG8_LAS unsigned*)(t + 256), 4, 0, 0);
        __builtin_amdgcn_global_load_lds((const unsigned*)(r0 + HALF), (PG8_LAS unsigned*)(t + 512), 4, 0, 0);
    }
    __device__ __forceinline__ void operator()(const i32x4 (&acc)[2][2][4][2], const Unit& u, int wr, int wc, int fr, int fq, const Pre&) const {
        const int row0 = u.pm * BM + wr * 64 + fr, cl = u.pn * HALF + wc * 32 + 8 * fq;
        bf16_t* base = O + cl;
        const PG8_LAS float* t = (const PG8_LAS float*)(scr + (wr * 4 + wc) * 768);
        f32x2 cg[4], cu[4];
#pragma unroll
        for (int q = 0; q < 2; ++q) { const f32x4 a = *(const PG8_LAS f32x4*)(t + 8 * fq + 4 * q) * (-1.4426950408889634f / 127.0f), b = *(const PG8_LAS f32x4*)(t + 32 + 8 * fq + 4 * q) * (-0.6931471805599453f / 127.0f);
            cg[2 * q] = (f32x2){a[0], a[1]}; cg[2 * q + 1] = (f32x2){a[2], a[3]}; cu[2 * q] = (f32x2){b[0], b[1]}; cu[2 * q + 1] = (f32x2){b[2], b[3]}; }
        float rsv[2][4];
#pragma unroll
        for (int ai = 0; ai < 2; ++ai)
#pragma unroll
            for (int m = 0; m < 4; ++m) rsv[ai][m] = t[64 + 64 * ai + 16 * m + fr];
#pragma unroll
        for (int ai = 0; ai < 2; ++ai)
#pragma unroll
            for (int m = 0; m < 4; ++m) { const int row = row0 + ai * HALF + m * 16; const f32x2 rs2 = (f32x2){rsv[ai][m], rsv[ai][m]}; bf16_t* rowp = base + (size_t)row * 5504;
                unsigned w[4];
#pragma unroll
                for (int p = 0; p < 4; ++p) { const int n = p >> 1, j = 2 * (p & 1);
                    const f32x2 G = (f32x2){(float)acc[ai][0][m][n][j], (float)acc[ai][0][m][n][j + 1]}, U = (f32x2){(float)acc[ai][1][m][n][j], (float)acc[ai][1][m][n][j + 1]};
                    const f32x2 T = (G * cg[p]) * rs2, V = (U * cu[p]) * rs2;
                    f32x2 D = (f32x2){__builtin_amdgcn_exp2f(T.x), __builtin_amdgcn_exp2f(T.y)} + (f32x2){1.0f, 1.0f};
                    const f32x2 R = (f32x2){__builtin_amdgcn_rcpf(D.x), __builtin_amdgcn_rcpf(D.y)};
                    const f32x2 Hh = (T * V) * R; w[p] = cvt_pk_bf16(Hh.x, Hh.y); }
                u32x4 wv4; wv4.x = w[0]; wv4.y = w[1]; wv4.z = w[2]; wv4.w = w[3];
                *(u32x4*)rowp = wv4; }
    }
};
struct EpiResidI8 {
    static constexpr bool PERM = false, AFTER_DRAIN = false, L2PF = true; typedef i32x4 acc_t;
    const bf16_t* src_lat; void* dst_lat; int dst_bf; const float* gate; float gs; bf16_t* part; const float* rowscale; const float* wmax;
    struct Pre {}; __device__ __forceinline__ void prefetch(Pre&, const Unit&, int, int, int, int) const {}
    __device__ __forceinline__ void l2pf(const Unit& u, int wid, int lane, PG8_LAS unsigned char* dummy) const {
        if (u.piece >= 0) return;
#pragma unroll
        for (int k = 0; k < 2; ++k) { const int li = wid * 128 + k * 64 + lane, row = li >> 2, seg = li & 3;
            __builtin_amdgcn_global_load_lds((const unsigned*)(src_lat + ((size_t)u.pm * BM + row) * 2048 + u.pn * BM + seg * 64), (PG8_LAS unsigned*)(dummy + wid * 512 + k * 256), 4, 0, 0); }
    }
    __device__ __forceinline__ void operator()(const i32x4 (&acc)[2][2][4][2], const Unit& u, int wr, int wc, int fr, int fq, const Pre&) const {
        int frx = fr, fqx = fq; asm volatile("" : "+v"(frx), "+v"(fqx));
        const int rl = wr * 64 + frx, col0 = u.pn * BM + wc * 32 + 4 * fqx;
        f32x4 wv[2][2];
#pragma unroll
        for (int bj = 0; bj < 2; ++bj)
#pragma unroll
            for (int n = 0; n < 2; ++n) wv[bj][n] = *(const f32x4*)(wmax + col0 + bj * HALF + n * 16) * (1.0f / 127.0f);
        float rsv[2][4]; { const float* rsp = rowscale + (size_t)u.pm * BM + rl;
#pragma unroll
            for (int ai = 0; ai < 2; ++ai)
#pragma unroll
                for (int m = 0; m < 4; ++m) rsv[ai][m] = rsp[ai * HALF + m * 16]; }
        __builtin_amdgcn_sched_barrier(0);
        if (u.piece >= 0) { bf16_t* pb = part + ((size_t)u.piece * 1024 + (size_t)(u.pm - 64) * BM + rl) * 2048 + col0;
#pragma unroll
            for (int ai = 0; ai < 2; ++ai)
#pragma unroll
                for (int m = 0; m < 4; ++m) { const float rs = rsv[ai][m];
#pragma unroll
                    for (int bj = 0; bj < 2; ++bj)
#pragma unroll
                        for (int n = 0; n < 2; ++n) { const i32x4 c = acc[ai][bj][m][n]; const f32x4 v = (f32x4){(float)c[0], (float)c[1], (float)c[2], (float)c[3]} * (wv[bj][n] * rs);
                            u32x2p w; w.x = cvt_pk_bf16(v[0], v[1]); w.y = cvt_pk_bf16(v[2], v[3]); *(u32x2p*)(pb + (size_t)(ai * HALF + m * 16) * 2048 + bj * HALF + n * 16) = w; } }
            return; }
        const int slot = u.pm >> 4;
        const float* gp = gate + (size_t)slot * (9 * 2048) + col0;
        const size_t e0 = ((size_t)u.pm * BM + rl) * 2048 + col0;
#pragma unroll
        for (int bj = 0; bj < 2; ++bj)
#pragma unroll
            for (int n = 0; n < 2; ++n) wv[bj][n] *= *(const f32x4*)(gp + bj * HALF + n * 16) * gs;
        if (dst_bf) rows<true, true>(acc, e0, wv, rsv); else rows<true, false>(acc, e0, wv, rsv);
    }
    template <bool SB, bool DB>
    __device__ __forceinline__ void rows(const i32x4 (&acc)[2][2][4][2], size_t e0, const f32x4 (&wv)[2][2], const float (&rsv)[2][4]) const {
        asm volatile("s_waitcnt vmcnt(0)" ::: "memory");
        u32x2p xr[2][2]; xl4(xr, src_lat + e0);
#pragma unroll
        for (int g = 0; g < 8; ++g) { const int ai = g >> 2, m = g & 3; const size_t er = e0 + (size_t)(ai * HALF + m * 16) * 2048; const float rs = rsv[ai][m];
            if (g == 0) xw4<0>(xr); else xw4<DB ? 4 : 4>(xr);
            f32x4 yy[2][2];
#pragma unroll
            for (int bj = 0; bj < 2; ++bj)
#pragma unroll
                for (int n = 0; n < 2; ++n) { const i32x4 c = acc[ai][bj][m][n]; const u32x2p xw = xr[bj][n];
                    const f32x4 x = (f32x4){__uint_as_float(xw.x << 16), __uint_as_float(xw.x & 0xffff0000u), __uint_as_float(xw.y << 16), __uint_as_float(xw.y & 0xffff0000u)};
                    yy[bj][n] = x + (f32x4){(float)c[0], (float)c[1], (float)c[2], (float)c[3]} * (wv[bj][n] * rs); }
            __builtin_amdgcn_sched_barrier(0);
            if (g < 7) xl4(xr, src_lat + e0 + (size_t)(((g + 1) >> 2) * HALF + ((g + 1) & 3) * 16) * 2048);
            __builtin_amdgcn_sched_barrier(0);
#pragma unroll
            for (int bj = 0; bj < 2; ++bj)
#pragma unroll
                for (int n = 0; n < 2; ++n) { const size_t e = er + bj * HALF + n * 16;
                    if constexpr (DB) { u32x2p w; w.x = cvt_pk_bf16(yy[bj][n][0], yy[bj][n][1]); w.y = cvt_pk_bf16(yy[bj][n][2], yy[bj][n][3]); *(u32x2p*)((bf16_t*)dst_lat + e) = w; } else *(f32x4*)((float*)dst_lat + e) = yy[bj][n]; }
            __builtin_amdgcn_sched_barrier(0); }
    }
};
struct EpiBf16I8 {
    static constexpr bool PERM = true, AFTER_DRAIN = false, L2PF = false; typedef i32x4 acc_t;
    bf16_t* O; int ldc; const float* rowscale; const float* wmax;
    struct Pre {}; __device__ __forceinline__ void prefetch(Pre&, const Unit&, int, int, int, int) const {}
    __device__ __forceinline__ void operator()(const i32x4 (&acc)[2][2][4][2], const Unit& u, int wr, int wc, int fr, int fq, const Pre&) const {
        const int row0 = u.pm * BM + wr * 64 + fr, col0 = u.pn * BM + wc * 32 + 8 * fq;
        f32x4 wv[2][2];
#pragma unroll
        for (int bj = 0; bj < 2; ++bj)
#pragma unroll
            for (int n = 0; n < 2; ++n) wv[bj][n] = *(const f32x4*)(wmax + col0 + bj * HALF + 4 * n) * (1.0f / 127.0f);
        float rsv[2][4];
#pragma unroll
        for (int ai = 0; ai < 2; ++ai)
#pragma unroll
            for (int m = 0; m < 4; ++m) rsv[ai][m] = rowscale[row0 + ai * HALF + m * 16];
        __builtin_amdgcn_sched_barrier(0);
#pragma unroll
        for (int ai = 0; ai < 2; ++ai)
#pragma unroll
            for (int m = 0; m < 4; ++m) { const int row = row0 + ai * HALF + m * 16; const float rs = rsv[ai][m]; bf16_t* rowp = O + (size_t)row * ldc + col0;
#pragma unroll
                for (int bj = 0; bj < 2; ++bj) { const i32x4 c0 = acc[ai][bj][m][0], c1 = acc[ai][bj][m][1]; const f32x4 s0 = wv[bj][0] * rs, s1 = wv[bj][1] * rs;
                    u32x4 w; w.x = cvt_pk_bf16((float)c0[0] * s0[0], (float)c0[1] * s0[1]); w.y = cvt_pk_bf16((float)c0[2] * s0[2], (float)c0[3] * s0[3]);
                    w.z = cvt_pk_bf16((float)c1[0] * s1[0], (float)c1[1] * s1[1]); w.w = cvt_pk_bf16((float)c1[2] * s1[2], (float)c1[3] * s1[3]);
                    *(u32x4*)(rowp + bj * HALF) = w; } }
    }
};
struct EpiQKNormI8 {
    static constexpr bool PERM = true, AFTER_DRAIN = false, L2PF = false; typedef i32x4 acc_t;
    bf16_t* O; int ldc; const float* rowscale; const float* wmax; const float* qg; const float* kg; int nq, nk; PG8_LAS float* ex;
    struct Pre {}; __device__ __forceinline__ void prefetch(Pre&, const Unit&, int, int, int, int) const {}
    __device__ __forceinline__ void operator()(const i32x4 (&acc)[2][2][4][2], const Unit& u, int wr, int wc, int fr, int fq, const Pre&) const {
        const int row0 = u.pm * BM + wr * 64 + fr, col0 = u.pn * BM + wc * 32 + 8 * fq;
        f32x4 wv[2][2];
#pragma unroll
        for (int bj = 0; bj < 2; ++bj)
#pragma unroll
            for (int n = 0; n < 2; ++n) wv[bj][n] = *(const f32x4*)(wmax + col0 + bj * HALF + 4 * n) * (1.0f / 127.0f);
        float rsv[2][4];
#pragma unroll
        for (int ai = 0; ai < 2; ++ai)
#pragma unroll
            for (int m = 0; m < 4; ++m) rsv[ai][m] = rowscale[row0 + ai * HALF + m * 16];
        const float* gain = u.pn < nq ? qg : kg; const bool normed = u.pn < nq + nk;
        f32x4 g0 = (f32x4){1.f, 1.f, 1.f, 1.f}, g1 = g0;
        if (normed) { g0 = *(const f32x4*)(gain + wc * 32 + 8 * fq); g1 = *(const f32x4*)(gain + wc * 32 + 8 * fq + 4); }
        __builtin_amdgcn_sched_barrier(0);
        float rn[2][2][4];
        if (normed) {
            PG8_LAS float* exw = ex + ((wr * 8) * 16 + fr) * 8 + wc;
#pragma unroll
            for (int ai = 0; ai < 2; ++ai)
#pragma unroll
                for (int m = 0; m < 4; ++m) { const float rs = rsv[ai][m];
#pragma unroll
                    for (int bj = 0; bj < 2; ++bj) { const i32x4 c0 = acc[ai][bj][m][0], c1 = acc[ai][bj][m][1]; const f32x4 s0 = wv[bj][0] * rs, s1 = wv[bj][1] * rs;
                        const f32x4 a = (f32x4){(float)c0[0], (float)c0[1], (float)c0[2], (float)c0[3]} * s0, b = (f32x4){(float)c1[0], (float)c1[1], (float)c1[2], (float)c1[3]} * s1;
                        float ss = (a[0] * a[0] + a[1] * a[1]) + (a[2] * a[2] + a[3] * a[3]) + (b[0] * b[0] + b[1] * b[1]) + (b[2] * b[2] + b[3] * b[3]);
                        ss += __int_as_float(__builtin_amdgcn_ds_swizzle(__float_as_int(ss), (16 << 10) | 0x1f));
                        { auto rr = __builtin_amdgcn_permlane32_swap(__float_as_uint(ss), __float_as_uint(ss), false, false); ss = __uint_as_float(rr[0]) + __uint_as_float(rr[1]); }
                        if (fq == 0) exw[((ai * 4 + m) * 16) * 8 + bj * 4] = ss; } }
            asm volatile("s_waitcnt lgkmcnt(0)" ::: "memory"); __builtin_amdgcn_s_barrier(); asm volatile("" ::: "memory");
            const PG8_LAS float* exr = ex + ((wr * 8) * 16 + fr) * 8;
#pragma unroll
            for (int ai = 0; ai < 2; ++ai)
#pragma unroll
                for (int m = 0; m < 4; ++m)
#pragma unroll
                    for (int bj = 0; bj < 2; ++bj) { const f32x4 p = *(const PG8_LAS f32x4*)(exr + ((ai * 4 + m) * 16) * 8 + bj * 4); rn[ai][bj][m] = 1.0f / sqrtf(((p[0] + p[1]) + (p[2] + p[3])) * (1.0f / 128.0f) + 1e-6f); }
        } else {
#pragma unroll
            for (int ai = 0; ai < 2; ++ai)
#pragma unroll
                for (int m = 0; m < 4; ++m) { rn[ai][0][m] = 1.f; rn[ai][1][m] = 1.f; }
        }
#pragma unroll
        for (int ai = 0; ai < 2; ++ai)
#pragma unroll
            for (int m = 0; m < 4; ++m) { const int row = row0 + ai * HALF + m * 16; const float rs = rsv[ai][m]; bf16_t* rowp = O + (size_t)row * ldc + col0;
#pragma unroll
                for (int bj = 0; bj < 2; ++bj) { const i32x4 c0 = acc[ai][bj][m][0], c1 = acc[ai][bj][m][1]; const float t = rs * rn[ai][bj][m]; const f32x4 s0 = wv[bj][0] * g0 * t, s1 = wv[bj][1] * g1 * t;
                    u32x4 w; w.x = cvt_pk_bf16((float)c0[0] * s0[0], (float)c0[1] * s0[1]); w.y = cvt_pk_bf16((float)c0[2] * s0[2], (float)c0[3] * s0[3]);
                    w.z = cvt_pk_bf16((float)c1[0] * s1[0], (float)c1[1] * s1[1]); w.w = cvt_pk_bf16((float)c1[2] * s1[2], (float)c1[3] * s1[3]);
                    *(u32x4*)(rowp + bj * HALF) = w; } }
    }
};
struct EpiQKRopeBf16 {
    static constexpr bool PERM = true, AFTER_DRAIN = false, L2PF = false; typedef f32x4 acc_t;
    static constexpr int QT0 = 8, NQT = 4;
    bf16_t* O; int ldc; const float* qkg; const float* rope; PG8_LAS float* ex;
    struct Pre {}; __device__ __forceinline__ void prefetch(Pre&, const Unit&, int, int, int, int) const {}
    __device__ __forceinline__ void operator()(const f32x4 (&acc)[2][2][4][2], const Unit& u, int wr, int wc, int fr, int fq, const Pre&) const {
        const int row0 = u.pm * BM + wr * 64 + fr, col0 = u.pn * BM + wc * 32 + 8 * fq;
        if (u.pn < QT0 || u.pn > QT0 + NQT) {
#pragma unroll
            for (int ai = 0; ai < 2; ++ai)
#pragma unroll
                for (int m = 0; m < 4; ++m) { bf16_t* rowp = O + (size_t)(row0 + ai * HALF + m * 16) * ldc + col0;
#pragma unroll
                    for (int bj = 0; bj < 2; ++bj) { const f32x4 v0 = acc[ai][bj][m][0], v1 = acc[ai][bj][m][1];
                        u32x4 w; w.x = cvt_pk_bf16(v0[0], v0[1]); w.y = cvt_pk_bf16(v0[2], v0[3]); w.z = cvt_pk_bf16(v1[0], v1[1]); w.w = cvt_pk_bf16(v1[2], v1[3]);
                        *(u32x4*)(rowp + bj * HALF) = w; } }
            return; }
        const float* gain = qkg + (u.pn < QT0 + NQT ? 0 : 128) + wc * 32 + 8 * fq;
        const f32x4 g0 = *(const f32x4*)gain, g1 = *(const f32x4*)(gain + 4);
        float rn[2][2][4];
        { PG8_LAS float* exw = ex + ((wr * 8) * 16 + fr) * 8 + wc;
#pragma unroll
          for (int ai = 0; ai < 2; ++ai)
#pragma unroll
            for (int m = 0; m < 4; ++m)
#pragma unroll
                for (int bj = 0; bj < 2; ++bj) { const f32x4 a = acc[ai][bj][m][0], b = acc[ai][bj][m][1];
                    float ss = (a[0] * a[0] + a[1] * a[1]) + (a[2] * a[2] + a[3] * a[3]) + (b[0] * b[0] + b[1] * b[1]) + (b[2] * b[2] + b[3] * b[3]);
                    ss += __int_as_float(__builtin_amdgcn_ds_swizzle(__float_as_int(ss), (16 << 10) | 0x1f));
                    { auto rr = __builtin_amdgcn_permlane32_swap(__float_as_uint(ss), __float_as_uint(ss), false, false); ss = __uint_as_float(rr[0]) + __uint_as_float(rr[1]); }
                    if (fq == 0) exw[((ai * 4 + m) * 16) * 8 + bj * 4] = ss; }
          asm volatile("s_waitcnt lgkmcnt(0)" ::: "memory"); __builtin_amdgcn_s_barrier(); asm volatile("" ::: "memory");
          const PG8_LAS float* exr = ex + ((wr * 8) * 16 + fr) * 8;
#pragma unroll
          for (int ai = 0; ai < 2; ++ai)
#pragma unroll
            for (int m = 0; m < 4; ++m)
#pragma unroll
                for (int bj = 0; bj < 2; ++bj) { const f32x4 p = *(const PG8_LAS f32x4*)(exr + ((ai * 4 + m) * 16) * 8 + bj * 4); rn[ai][bj][m] = 1.0f / sqrtf(((p[0] + p[1]) + (p[2] + p[3])) * (1.0f / 128.0f) + 1e-6f); } }
        const bool rot = u.pm < 64;
        const float* rbase = rope + (16 * (wc & 1) + 4 * fq) * 2;
#pragma unroll
        for (int ai = 0; ai < 2; ++ai) {
            f32x4 cs[4][2];
#pragma unroll
            for (int m = 0; m < 4; ++m) { const int t = (row0 + ai * HALF + m * 16) & 4095, pos = rot ? ((wc >> 1) ? (t & 63) : (t >> 6)) : 0;
#pragma unroll
                for (int n = 0; n < 2; ++n) cs[m][n] = *(const f32x4*)(rbase + (size_t)pos * 64 + 4 * n); }
            __builtin_amdgcn_sched_barrier(0);
#pragma unroll
            for (int m = 0; m < 4; ++m) { bf16_t* rowp = O + (size_t)(row0 + ai * HALF + m * 16) * ldc + col0;
#pragma unroll
                for (int bj = 0; bj < 2; ++bj) { const float t = rn[ai][bj][m]; unsigned wd[4];
#pragma unroll
                    for (int n = 0; n < 2; ++n) { const f32x4 y = acc[ai][bj][m][n] * ((n ? g1 : g0) * t); f32x4 c = cs[m][n]; if (!rot) c = (f32x4){1.f, 0.f, 1.f, 0.f};
                        wd[2 * n] = cvt_pk_bf16(y[0] * c[0] - y[1] * c[1], y[1] * c[0] + y[0] * c[1]); wd[2 * n + 1] = cvt_pk_bf16(y[2] * c[2] - y[3] * c[3], y[3] * c[2] + y[2] * c[3]); }
                    u32x4 w; w.x = wd[0]; w.y = wd[1]; w.z = wd[2]; w.w = wd[3];
                    *(u32x4*)(rowp + bj * HALF) = w; } } }
    }
};
template <class Epi, class Sched, bool ALIGN_EPI = false, bool SP2 = false>
__device__ __forceinline__ void gemm_phase(PG8_LAS unsigned char* lds, const Gemm g, const Sched& S, const Epi& E) {
    int tid = threadIdx.x; asm volatile("" : "+v"(tid));
    const int wid = __builtin_amdgcn_readfirstlane(tid >> 6), lane = tid & 63, wr = wid >> 2, wc = wid & 3, fr = lane & 15, fq = lane >> 4;
    const int K = g.K;
    unsigned voffA[2], voffB[2];
#pragma unroll
    for (int i = 0; i < 2; ++i) { int R, C; stage_rc(tid * 16 + i * 8192, R, C); const int Rb = Epi::PERM ? ((R & ~31) + perm32(R & 31)) : R;
        voffA[i] = (unsigned)R * (unsigned)g.pitchA + (unsigned)C * 2u; voffB[i] = (unsigned)Rb * (unsigned)g.pitchB + (unsigned)C * 2u; }
    const size_t kstepA = g.kstepA, kstepB = g.kstepB;
    const size_t hstepA = (size_t)HALF * g.pitchA, hstepB = (size_t)HALF * g.pitchB;
    const size_t tstepA = 2 * hstepA, tstepB = 2 * hstepB;
    const unsigned ldsw = (unsigned)wid * 1024u;
    const int aoff = lds_byte(wr * 64 + fr, fq * 8), boff = lds_byte(wc * 32 + fr, fq * 8);
#define PG8_SA(b, h) (((b) * 2 + (h)) * HTB)
#define PG8_SB(b, h) ((4 + (b) * 2 + (h)) * HTB)
#define PG8_STAGE(bufoff, gbase, voff) do { _Pragma("unroll") for (int _i = 0; _i < 2; ++_i) \
        __builtin_amdgcn_global_load_lds((const unsigned*)((const char*)(gbase) + (voff)[_i]), (PG8_LAS unsigned*)(lds + (bufoff) + ldsw + _i * 8192), 16, 0, 0); } while (0)
#define PG8_LDA(dst, b, h) do { _Pragma("unroll") for (int m = 0; m < 4; ++m) _Pragma("unroll") for (int k = 0; k < 2; ++k) dst[m][k] = *(const PG8_LAS bf16x8*)(lds + PG8_SA(b, h) + aoff + m * 2048 + k * 1024); } while (0)
#define PG8_LDB(dst, b, h) do { _Pragma("unroll") for (int n = 0; n < 2; ++n) _Pragma("unroll") for (int k = 0; k < 2; ++k) dst[n][k] = *(const PG8_LAS bf16x8*)(lds + PG8_SB(b, h) + boff + n * 2048 + k * 1024); } while (0)
#define PG8_MMA(ai, bj, At, Bt) do { __builtin_amdgcn_s_setprio(1); _Pragma("unroll") for (int m = 0; m < 4; ++m) _Pragma("unroll") for (int n = 0; n < 2; ++n) _Pragma("unroll") for (int k = 0; k < 2; ++k) \
        acc[ai][bj][m][n] = mma16(Bt[n][k], At[m][k], acc[ai][bj][m][n]); __builtin_amdgcn_s_setprio(0); } while (0)
#define PG8_WAIT_V(n) asm volatile("s_waitcnt vmcnt(" #n ")" ::: "memory")
#define PG8_WAIT_L(n) asm volatile("s_waitcnt lgkmcnt(" #n ")" ::: "memory")
#define PG8_BAR __builtin_amdgcn_s_barrier()
#define PG8_SCHED __builtin_amdgcn_sched_barrier(0)
    Unit cur, nxt; int ui = 0;
    if (!S.next(0, cur)) return;
    typedef typename Epi::acc_t acc_t;
    acc_t acc[2][2][4][2];
#pragma unroll
    for (int a = 0; a < 2; ++a)
#pragma unroll
        for (int b = 0; b < 2; ++b)
#pragma unroll
            for (int m = 0; m < 4; ++m)
#pragma unroll
                for (int n = 0; n < 2; ++n) acc[a][b][m][n] = acc_t{};
    bf16x8 At[4][2], B0[2][2], B1[2][2];
    const char* cA = (const char*)g.A + (size_t)cur.pm * tstepA + (size_t)cur.kt0 * kstepA; const char* cB = (const char*)g.Bt + (size_t)cur.pn * tstepB + (size_t)cur.kt0 * kstepB;
    S.a_ready(cur);
    typename Epi::Pre pre; E.prefetch(pre, cur, wr, wc, fr, fq);
    if constexpr (SP2) {
        PG8_STAGE(PG8_SB(0, 0), cB, voffB); PG8_STAGE(PG8_SB(0, 1), cB + hstepB, voffB); PG8_STAGE(PG8_SA(0, 0), cA, voffA); PG8_STAGE(PG8_SA(0, 1), cA + hstepA, voffA);
        if (wr == 1) PG8_BAR;
        PG8_WAIT_V(2); PG8_BAR;
        PG8_STAGE(PG8_SB(1, 0), cB + kstepB, voffB); PG8_STAGE(PG8_SA(1, 0), cA + kstepA, voffA); PG8_STAGE(PG8_SB(1, 1), cB + hstepB + kstepB, voffB);
        PG8_WAIT_V(6); PG8_BAR;
    } else {
        PG8_STAGE(PG8_SB(0, 0), cB, voffB); PG8_STAGE(PG8_SA(0, 0), cA, voffA); PG8_STAGE(PG8_SB(0, 1), cB + hstepB, voffB); PG8_STAGE(PG8_SA(0, 1), cA + hstepA, voffA);
        if (wr == 1) PG8_BAR;
        PG8_WAIT_V(4); PG8_BAR;
        PG8_STAGE(PG8_SB(1, 0), cB + kstepB, voffB); PG8_STAGE(PG8_SA(1, 0), cA + kstepA, voffA); PG8_STAGE(PG8_SB(1, 1), cB + hstepB + kstepB, voffB);
        PG8_WAIT_V(6); PG8_BAR;
    }
    for (;;) {
        const bool has_next = S.next(ui + 1, nxt);
        const char* nA = has_next ? (const char*)g.A + (size_t)nxt.pm * tstepA + (size_t)nxt.kt0 * kstepA : cA; const char* nB = has_next ? (const char*)g.Bt + (size_t)nxt.pn * tstepB + (size_t)nxt.kt0 * kstepB : cB;
        const int nt = cur.nkt;
        for (int t = 0; t < nt; t += 2) {
            if constexpr (Epi::L2PF) { if (t == nt - 4) E.l2pf(cur, wid, lane, lds + 135168); }
            const bool last = (t == nt - 2);
            const char* a1 = cA + (size_t)(t + 1) * kstepA;
            const char* a2 = last ? nA : cA + (size_t)(t + 2) * kstepA; const char* b2 = last ? nB : cB + (size_t)(t + 2) * kstepB;
            const char* a3 = a2 + kstepA; const char* b3 = b2 + kstepB;
            if (last && has_next) S.a_ready(nxt);
            if constexpr (SP2) {
            PG8_LDB(B0, 0, 0); PG8_LDB(B1, 0, 1); PG8_SCHED; PG8_LDA(At, 0, 0); PG8_STAGE(PG8_SA(1, 1), a1 + hstepA, voffA);
            PG8_WAIT_V(8); PG8_WAIT_L(0); PG8_BAR; PG8_MMA(0, 0, At, B0); PG8_MMA(0, 1, At, B1); PG8_BAR; PG8_SCHED;
            PG8_LDA(At, 0, 1); PG8_STAGE(PG8_SB(0, 0), b2, voffB); PG8_STAGE(PG8_SB(0, 1), b2 + hstepB, voffB); PG8_STAGE(PG8_SA(0, 0), a2, voffA);
            PG8_WAIT_V(8); PG8_WAIT_L(0); PG8_BAR; PG8_MMA(1, 0, At, B0); PG8_MMA(1, 1, At, B1); PG8_BAR; PG8_SCHED;
            PG8_LDB(B0, 1, 0); PG8_LDB(B1, 1, 1); PG8_SCHED; PG8_LDA(At, 1, 0); PG8_STAGE(PG8_SA(0, 1), a2 + hstepA, voffA);
            PG8_WAIT_V(8); PG8_WAIT_L(0); PG8_BAR; PG8_MMA(0, 0, At, B0); PG8_MMA(0, 1, At, B1); PG8_BAR; PG8_SCHED;
            PG8_LDA(At, 1, 1); PG8_STAGE(PG8_SB(1, 0), b3, voffB); PG8_STAGE(PG8_SB(1, 1), b3 + hstepB, voffB); PG8_STAGE(PG8_SA(1, 0), a3, voffA);
            PG8_WAIT_V(8); PG8_WAIT_L(0); PG8_BAR; PG8_MMA(1, 0, At, B0); PG8_MMA(1, 1, At, B1); PG8_BAR; PG8_SCHED;
            } else {
            PG8_LDB(B0, 0, 0); PG8_SCHED; PG8_LDA(At, 0, 0); PG8_STAGE(PG8_SA(1, 1), a1 + hstepA, voffA);
            PG8_WAIT_L(8); PG8_BAR; PG8_WAIT_L(0); PG8_MMA(0, 0, At, B0); PG8_BAR; PG8_SCHED;
            PG8_LDB(B1, 0, 1); PG8_STAGE(PG8_SB(0, 0), b2, voffB);
            PG8_BAR; PG8_WAIT_L(0); PG8_MMA(0, 1, At, B1); PG8_BAR;
            PG8_LDA(At, 0, 1); PG8_STAGE(PG8_SA(0, 0), a2, voffA);
            PG8_BAR; PG8_WAIT_L(0); PG8_MMA(1, 0, At, B0); PG8_BAR; PG8_SCHED;
            PG8_STAGE(PG8_SB(0, 1), b2 + hstepB, voffB);
            PG8_WAIT_V(6); PG8_BAR; PG8_MMA(1, 1, At, B1); PG8_BAR;
            PG8_LDB(B0, 1, 0); PG8_SCHED; PG8_LDA(At, 1, 0); PG8_STAGE(PG8_SA(0, 1), a2 + hstepA, voffA);
            PG8_WAIT_L(8); PG8_BAR; PG8_WAIT_L(0); PG8_MMA(0, 0, At, B0); PG8_BAR; PG8_SCHED;
            PG8_LDB(B1, 1, 1); PG8_STAGE(PG8_SB(1, 0), b3, voffB);
            PG8_BAR; PG8_WAIT_L(0); PG8_MMA(0, 1, At, B1); PG8_BAR;
            PG8_LDA(At, 1, 1); PG8_STAGE(PG8_SA(1, 0), a3, voffA);
            PG8_BAR; PG8_WAIT_L(0); PG8_MMA(1, 0, At, B0); PG8_BAR; PG8_SCHED;
            PG8_STAGE(PG8_SB(1, 1), b3 + hstepB, voffB);
            PG8_WAIT_V(6); PG8_BAR; PG8_MMA(1, 1, At, B1); PG8_BAR;
            }
        }
        if constexpr (ALIGN_EPI) { if (wr == 0) PG8_BAR; }
        if constexpr (!Epi::AFTER_DRAIN) { E(acc, cur, wr, wc, fr, fq, pre); S.done(cur); }
        if (!has_next) break;
#pragma unroll
        for (int a = 0; a < 2; ++a)
#pragma unroll
            for (int b = 0; b < 2; ++b)
#pragma unroll
                for (int m = 0; m < 4; ++m)
#pragma unroll
                    for (int n = 0; n < 2; ++n) acc[a][b][m][n] = acc_t{};
        cur = nxt; cA = nA; cB = nB; ++ui;
        E.prefetch(pre, cur, wr, wc, fr, fq);
        if constexpr (ALIGN_EPI) { if (wr == 1) PG8_BAR; }
    }
    PG8_WAIT_V(0);
    if constexpr (!ALIGN_EPI) { if (wr == 0) PG8_BAR; }
    PG8_BAR;
    if constexpr (Epi::AFTER_DRAIN) { E.fused(acc, cur, wr, wc, fr, fq, lds, wid, lane); S.done(cur); }
#undef PG8_SA
#undef PG8_SB
#undef PG8_STAGE
#undef PG8_LDA
#undef PG8_LDB
#undef PG8_MMA
#undef PG8_WAIT_V
#undef PG8_WAIT_L
#undef PG8_BAR
#undef PG8_SCHED
}
}
constexpr int NWAVES = 8;
constexpr int DM = 2048, NBATCH = 4, SEQL = 4096, CTXL = 256, FF = 5504, FF2 = 11008;
constexpr int ML = NBATCH * SEQL, MC = NBATCH * CTXL, MT = ML + MC;
constexpr int ABN = 3584, NAN3 = 6144, MODW = 9 * DM;
constexpr float EPSN = 1e-6f;
constexpr float ATT_SCALE = 0.088388347648318440f;
#ifndef NPHASES_RUN
#define NPHASES_RUN 22
#endif
constexpr int N_PHASES = 22;
constexpr int HQP = 5632;
#ifndef GEMM_ALIGN
#define GEMM_ALIGN true
#endif
#ifndef G1_ALIGN
#define G1_ALIGN GEMM_ALIGN
#endif
#ifndef G2_ALIGN
#define G2_ALIGN GEMM_ALIGN
#endif
#ifndef G1_WGM
#define G1_WGM 4
#endif
#ifndef G2_WGM
#define G2_WGM 4
#endif
#ifndef HID_CLIP
#define HID_CLIP 1.0f
#endif
#ifndef P0_NPRO
#define P0_NPRO 3
#endif
#ifndef LRU_EXTRA
#define LRU_EXTRA 4
#endif
#ifndef NORM_LA
#define NORM_LA 4
#endif
#ifndef GEMM_SP2
#define GEMM_SP2 true
#endif

constexpr size_t MiB = 1u << 20;
constexpr size_t WS_CTL = 0, CTL_ZERO_BYTES = 1 * MiB;
constexpr size_t WS_MOD = 1 * MiB;
constexpr size_t WS_ROPE = 2 * MiB;
constexpr size_t WS_QKG = 2 * MiB + 65536;
constexpr size_t WS_CARRY = 3 * MiB;
constexpr size_t WS_HIN = 9 * MiB;
constexpr size_t WS_SH = 12 * MiB;
constexpr size_t WS_SQ = 13 * MiB;
constexpr size_t WS_SY = 14 * MiB;
constexpr size_t WS_WLRU = 8 * MiB;
constexpr size_t WS_WFI = 16 * MiB;
constexpr size_t WS_WFO = 188 * MiB;
constexpr size_t WS_WABI = 274 * MiB, WS_WABO = 288 * MiB, WS_WNAI = 296 * MiB, WS_WNAO = 320 * MiB;
constexpr size_t WS_X = 328 * MiB;
constexpr size_t WS_H = 464 * MiB;
constexpr size_t WS_BIG = 532 * MiB;
constexpr size_t WS_D = 788 * MiB;
constexpr size_t WS_END = 884 * MiB;
static_assert(WS_WFI + 4ull * FF2 * DM * 2 <= WS_WFO && WS_WFO + 4ull * DM * FF * 2 <= WS_WABI && WS_WABI + (size_t)ABN * DM * 2 <= WS_WABO && WS_WNAI + (size_t)NAN3 * DM * 2 <= WS_WNAO, "ws map (weights)");
static_assert(WS_X + (size_t)MT * DM * 4 <= WS_H && WS_H + (size_t)MT * DM * 2 <= WS_BIG && WS_BIG + (size_t)MT * NAN3 * 2 <= WS_D && WS_D + 44ull * MT * 128 <= WS_END, "ws map (activations)");
constexpr int CW_BAR = 4096;
constexpr size_t CTL_WMAX_IN = 64 * 1024, CTL_WMAX_OUT = CTL_WMAX_IN + 4 * FF2 * 4;
constexpr size_t CTL_WMAX_NAI = CTL_WMAX_OUT + 4 * DM * 4, CTL_WMAX_NAO = CTL_WMAX_NAI + NAN3 * 4;
static_assert(CTL_WMAX_NAO + DM * 4 <= 512 * 1024, "CTL map");

constexpr int RING_BYTES = 131072;
constexpr int LDSCTL_OFF = RING_BYTES, MISC_OFF = LDSCTL_OFF + 320;
constexpr int LDS_BYTES = 163840;
constexpr int LRU_U_OFF = RING_BYTES + 4096;

#define GAS __attribute__((address_space(1)))
#define LAS __attribute__((address_space(3)))
typedef unsigned short bf16;
typedef float f32x4 __attribute__((ext_vector_type(4)));
typedef float f32x2 __attribute__((ext_vector_type(2)));
typedef float f32x16 __attribute__((ext_vector_type(16)));
typedef short bf16x8 __attribute__((ext_vector_type(8)));
typedef short s16x4 __attribute__((ext_vector_type(4)));
typedef unsigned u32x4 __attribute__((ext_vector_type(4)));
typedef unsigned u32x2 __attribute__((ext_vector_type(2)));
#define RLX_AGENT __ATOMIC_RELAXED, __HIP_MEMORY_SCOPE_AGENT
#define LDS_WAIT() asm volatile("s_waitcnt lgkmcnt(0)" ::: "memory")
#define LDS_BARRIER() do { asm volatile("s_waitcnt lgkmcnt(0)" ::: "memory"); __builtin_amdgcn_s_barrier(); asm volatile("" ::: "memory"); } while (0)
__device__ __forceinline__ unsigned cvtpk(float lo, float hi) { unsigned r; asm volatile("v_cvt_pk_bf16_f32 %0, %1, %2" : "=v"(r) : "v"(lo), "v"(hi)); return r; }
__device__ __forceinline__ float bflo(unsigned w) { return __uint_as_float(w << 16); }
__device__ __forceinline__ float bfhi(unsigned w) { return __uint_as_float(w & 0xffff0000u); }
__device__ __forceinline__ unsigned short f2bf(float f) { return (unsigned short)(cvtpk(f, f) & 0xffffu); }
__device__ __forceinline__ void unpack8(const u32x4 w, float (&x)[8]) { x[0] = bflo(w.x); x[1] = bfhi(w.x); x[2] = bflo(w.y); x[3] = bfhi(w.y); x[4] = bflo(w.z); x[5] = bfhi(w.z); x[6] = bflo(w.w); x[7] = bfhi(w.w); }
__device__ __forceinline__ u32x4 pack8(const float (&x)[8]) { u32x4 w; w.x = cvtpk(x[0], x[1]); w.y = cvtpk(x[2], x[3]); w.z = cvtpk(x[4], x[5]); w.w = cvtpk(x[6], x[7]); return w; }
__device__ __forceinline__ float sigmoid_f(float x) { return __builtin_amdgcn_rcpf(1.0f + __builtin_amdgcn_exp2f(-1.4426950408889634f * x)); }
template <int M> __device__ __forceinline__ float swz_xor(float v) { return __int_as_float(__builtin_amdgcn_ds_swizzle(__float_as_int(v), (M << 10) | 0x1f)); }
__device__ __forceinline__ float half_sum(float v) { auto rr = __builtin_amdgcn_permlane32_swap(__float_as_uint(v), __float_as_uint(v), false, false); return __uint_as_float(rr[0]) + __uint_as_float(rr[1]); }
__device__ __forceinline__ float wave_max(float v) { v = fmaxf(v, swz_xor<1>(v)); v = fmaxf(v, swz_xor<2>(v)); v = fmaxf(v, swz_xor<4>(v)); v = fmaxf(v, swz_xor<8>(v)); v = fmaxf(v, swz_xor<16>(v));
    auto rr = __builtin_amdgcn_permlane32_swap(__float_as_uint(v), __float_as_uint(v), false, false); return fmaxf(__uint_as_float(rr[0]), __uint_as_float(rr[1])); }
__device__ __forceinline__ unsigned pack_i8x4(f32x4 y, float inv) {
    const f32x4 t = y * inv + 12582912.0f;
    const unsigned lo = __builtin_amdgcn_perm(__float_as_uint(t.y), __float_as_uint(t.x), 0x0c0c0400u), hi = __builtin_amdgcn_perm(__float_as_uint(t.w), __float_as_uint(t.z), 0x04000c0cu);
    return lo | hi; }
__device__ __forceinline__ float wave_sum(float v) { v += swz_xor<1>(v); v += swz_xor<2>(v); v += swz_xor<4>(v); v += swz_xor<8>(v); v += swz_xor<16>(v); return half_sum(v); }
#define XB_TMO      128
#define XB_XCNT(j)  (256  + 64 * (j))
#define XB_XSUB(j)  (1280 + 64 * (j))
#define XB_XGEN(j)  (2304 + 64 * (j))
#define XB_TOP      3328
#define XB_TOPGEN   3392
#define XCD_BAR_WORDS 3456
#define XB_SPIN_CAP (1u << 18)

__device__ __forceinline__ unsigned xb_ld(unsigned* p)              { return __hip_atomic_load(p, __ATOMIC_RELAXED, __HIP_MEMORY_SCOPE_AGENT); }
__device__ __forceinline__ unsigned xb_add(unsigned* p, unsigned v) { return __hip_atomic_fetch_add(p, v, __ATOMIC_RELAXED, __HIP_MEMORY_SCOPE_AGENT); }
__device__ __forceinline__ unsigned xb_xcc_id() { return (unsigned)__builtin_amdgcn_s_getreg((3 << 11) | 20) & 0xFu; }
#define XB_SPIN(cond, bar) do { unsigned _sp = 0; while (cond) { __builtin_amdgcn_s_sleep(1); \
    if ((++_sp & 255u) == 0u) { if (xb_ld(&(bar)[XB_TMO])) break; if (_sp > XB_SPIN_CAP) { atomicAdd(&(bar)[XB_TMO], 1u); break; } } } } while (0)

struct XcdBarrier {
    unsigned* bar; unsigned x;
    volatile LAS unsigned* st;
};

__device__ __forceinline__ XcdBarrier xcd_barrier_post(unsigned* bar, volatile LAS unsigned* st) {
    XcdBarrier b; b.bar = bar; b.x = xb_xcc_id(); b.st = st;
    if (threadIdx.x == 0) (void)xb_add(&bar[XB_XCNT(b.x)], 1u);
    return b;
}
__device__ __forceinline__ void xcd_barrier_complete(unsigned* bar, unsigned x, unsigned& nloc, unsigned& nx) {
    const unsigned G = gridDim.x * gridDim.y * gridDim.z;
    unsigned sum, cnt, mine, sp = 0u;
    for (;;) {
        sum = 0u; cnt = 0u; mine = 0u;
#pragma unroll
        for (unsigned j = 0; j < 16; ++j) { const unsigned c = xb_ld(&bar[XB_XCNT(j)]); sum += c; cnt += (c > 0u) ? 1u : 0u; mine = (j == x) ? c : mine; }
        if (sum == G) break;
        __builtin_amdgcn_s_sleep(1);
        if ((++sp & 255u) == 0u) { if (xb_ld(&bar[XB_TMO])) break; if (sp > XB_SPIN_CAP) { atomicAdd(&bar[XB_TMO], 1u); break; } }
    }
    nloc = mine > 0u ? mine : 1u; nx = cnt > 0u ? cnt : 1u;
}

__device__ __forceinline__ void xcd_barrier(const XcdBarrier& b) {
    asm volatile("s_waitcnt vmcnt(0)" ::: "memory");
    __syncthreads();
    if (threadIdx.x == 0) {
        unsigned* bar = b.bar; asm volatile("" : "+s"(bar));
        __builtin_amdgcn_s_waitcnt(0);
        unsigned nloc = b.st[0], nx = b.st[1];
        if (nloc == 0u) { xcd_barrier_complete(bar, b.x, nloc, nx); b.st[0] = nloc; b.st[1] = nx; }
        const unsigned old = xb_add(&bar[XB_XSUB(b.x)], 1u);
        const unsigned gen = old / nloc;
        if (old + 1u == (gen + 1u) * nloc) {
            __builtin_amdgcn_fence(__ATOMIC_RELEASE, "agent");
            asm volatile("s_waitcnt vmcnt(0)" ::: "memory");
            const unsigned og = xb_add(&bar[XB_TOP], 1u);
            const unsigned tg = og / nx;
            if (og + 1u == (tg + 1u) * nx) xb_add(&bar[XB_TOPGEN], 1u);
            else XB_SPIN(xb_ld(&bar[XB_TOPGEN]) == tg, bar);
            __builtin_amdgcn_fence(__ATOMIC_ACQUIRE, "agent");
            xb_add(&bar[XB_XGEN(b.x)], 1u);
            asm volatile("s_waitcnt vmcnt(0)" ::: "memory");
        } else {
            XB_SPIN(xb_ld(&bar[XB_XGEN(b.x)]) == gen, bar);
            __builtin_amdgcn_fence(__ATOMIC_ACQUIRE, "agent");
            asm volatile("s_waitcnt vmcnt(0)" ::: "memory");
        }
    }
    __syncthreads();
}
struct Args { const float* in[26]; float* out; unsigned char* ws; int ph_lo, ph_hi; };
enum { IN_X = 0, IN_C, IN_CTX, IN_CCTX, IN_WMOD, IN_BMOD, IN_NORMG, IN_FWI, IN_FWO, IN_ABWI, IN_CONVW, IN_CONVB, IN_LWA, IN_LBA, IN_LWX, IN_LBX, IN_LAM,
       IN_AQN, IN_AKN, IN_SINK, IN_ABWO, IN_NAWI, IN_NAQN, IN_NAKN, IN_RPB, IN_NAWO };

__device__ __forceinline__ void p0_transpose_item(const float* W, int ldw, int K, bf16* WT, int dst_row0, int src_col0, int k0, LAS float* scr, int lane, int tm_rows = 0) {
    { f32x4 t4[8];
#pragma unroll
      for (int i = 0; i < 8; ++i) t4[i] = *(const f32x4*)(W + (size_t)(k0 + 8 * i + (lane >> 3)) * ldw + src_col0 + 4 * (lane & 7));
#pragma unroll
      for (int i = 0; i < 8; ++i) { LAS float* sp = scr + (8 * i + (lane >> 3)) * 33 + 4 * (lane & 7); sp[0] = t4[i].x; sp[1] = t4[i].y; sp[2] = t4[i].z; sp[3] = t4[i].w; } }
    LDS_WAIT();
    const int c = lane & 7;
#pragma unroll
    for (int j = 0; j < 4; ++j) { const int n = (lane >> 3) + 8 * j; const LAS float* s = scr + (8 * c) * 33 + n;
        u32x4 o; o.x = cvtpk(s[0 * 33], s[1 * 33]); o.y = cvtpk(s[2 * 33], s[3 * 33]); o.z = cvtpk(s[4 * 33], s[5 * 33]); o.w = cvtpk(s[6 * 33], s[7 * 33]);
        bf16* dp = tm_rows ? WT + ((size_t)(k0 >> 6) * tm_rows + dst_row0 + n) * 64 + 8 * c : WT + (size_t)(dst_row0 + n) * K + k0 + 8 * c;
        *(u32x4*)dp = o; }
    LDS_WAIT();
}
__device__ __forceinline__ void p0_absmax_phase(const Args& a, int tid, int vc, int VG, int set) {
    asm volatile("" : "+v"(tid)); const int lane = tid & 63, wave = __builtin_amdgcn_readfirstlane(tid >> 6);
    unsigned* wmax_in = (unsigned*)(a.ws + WS_CTL + CTL_WMAX_IN); unsigned* wmax_out = (unsigned*)(a.ws + WS_CTL + CTL_WMAX_OUT);
    constexpr int I_IN = 43 * 16, I_OUT = 8 * 43, I_NAI = 24 * 16, I_NAO = 8 * 16;
    const int nloc = set < 4 ? I_IN + I_OUT : I_NAI + I_NAO;
    for (int il = vc * NWAVES + wave; il < nloc; il += VG * NWAVES) {
        const int it = set < 4 ? (il < I_IN ? set * I_IN + il : 4 * I_IN + set * I_OUT + (il - I_IN)) : 4 * (I_IN + I_OUT) + il;
        const float* W; int ldw, c0, k0; unsigned* dst;
        if (it < 4 * I_IN) { const int m = it / I_IN, q = it % I_IN; c0 = (q % 43) * 256; k0 = (q / 43) * 128; ldw = FF2; W = a.in[IN_FWI] + (size_t)m * DM * FF2; dst = wmax_in + m * FF2 + c0; }
        else if (it < 4 * (I_IN + I_OUT)) { const int r = it - 4 * I_IN, m = r / I_OUT, q = r % I_OUT; c0 = (q % 8) * 256; k0 = (q / 8) * 128; ldw = DM; W = a.in[IN_FWO] + (size_t)m * FF * DM; dst = wmax_out + m * DM + c0; }
        else if (it < 4 * (I_IN + I_OUT) + I_NAI) { const int q = it - 4 * (I_IN + I_OUT); c0 = (q % 24) * 256; k0 = (q / 24) * 128; ldw = NAN3; W = a.in[IN_NAWI]; dst = (unsigned*)(a.ws + WS_CTL + CTL_WMAX_NAI) + c0; }
        else { const int q = it - 4 * (I_IN + I_OUT) - I_NAI; c0 = (q % 8) * 256; k0 = (q / 8) * 128; ldw = DM; W = a.in[IN_NAWO]; dst = (unsigned*)(a.ws + WS_CTL + CTL_WMAX_NAO) + c0; }
        const float* wp = W + (size_t)k0 * ldw + c0 + lane * 4; f32x4 mx = (f32x4){0.f, 0.f, 0.f, 0.f};
#pragma unroll 16
        for (int i = 0; i < 128; ++i) { const f32x4 v = *(const f32x4*)(wp + (size_t)i * ldw); mx.x = fmaxf(mx.x, fabsf(v.x)); mx.y = fmaxf(mx.y, fabsf(v.y)); mx.z = fmaxf(mx.z, fabsf(v.z)); mx.w = fmaxf(mx.w, fabsf(v.w)); }
        atomicMax(dst + lane * 4 + 0, __float_as_uint(mx.x)); atomicMax(dst + lane * 4 + 1, __float_as_uint(mx.y)); atomicMax(dst + lane * 4 + 2, __float_as_uint(mx.z)); atomicMax(dst + lane * 4 + 3, __float_as_uint(mx.w));
    }
}
__device__ __forceinline__ void p0_quant_item(const float* W, int ldw, int Kp, signed char* WT, int dst_row0, int src_col0, int k0, const float* wmax, LAS float* scr, int lane) {
    { f32x4 t4[8];
#pragma unroll
      for (int i = 0; i < 8; ++i) t4[i] = *(const f32x4*)(W + (size_t)(k0 + 8 * i + (lane >> 3)) * ldw + src_col0 + 4 * (lane & 7));
#pragma unroll
      for (int i = 0; i < 8; ++i) { LAS float* sp = scr + (8 * i + (lane >> 3)) * 33 + 4 * (lane & 7); sp[0] = t4[i].x; sp[1] = t4[i].y; sp[2] = t4[i].z; sp[3] = t4[i].w; } }
    LDS_WAIT();
    const int c = lane & 7;
#pragma unroll
    for (int j = 0; j < 4; ++j) { const int n = (lane >> 3) + 8 * j; const LAS float* s = scr + (8 * c) * 33 + n; const float inv = 127.0f / fmaxf(wmax[src_col0 + n], 1e-30f);
        int qv[8];
#pragma unroll
        for (int e = 0; e < 8; ++e) { int v = (int)rintf(s[e * 33] * inv); v = v > 127 ? 127 : (v < -127 ? -127 : v); qv[e] = v & 255; }
        u32x2 o; o.x = (unsigned)(qv[0] | (qv[1] << 8) | (qv[2] << 16) | (qv[3] << 24)); o.y = (unsigned)(qv[4] | (qv[5] << 8) | (qv[6] << 16) | (qv[7] << 24));
        *(u32x2*)(WT + (size_t)(dst_row0 + n) * Kp + k0 + 8 * c) = o; }
    LDS_WAIT();
}
__device__ __forceinline__ void p0_quant_item_tm(const float* W, int ldw, int nrows, signed char* WT, int dst_row0, int src_col0, int k0, const float* wmax, LAS float* scr, int lane) {
    { f32x4 t4[8];
#pragma unroll
      for (int i = 0; i < 8; ++i) t4[i] = *(const f32x4*)(W + (size_t)(k0 + 8 * i + (lane >> 3)) * ldw + src_col0 + 4 * (lane & 7));
#pragma unroll
      for (int i = 0; i < 8; ++i) { LAS float* sp = scr + (8 * i + (lane >> 3)) * 33 + 4 * (lane & 7); sp[0] = t4[i].x; sp[1] = t4[i].y; sp[2] = t4[i].z; sp[3] = t4[i].w; } }
    LDS_WAIT();
    const int c = lane & 7;
#pragma unroll
    for (int j = 0; j < 4; ++j) { const int n = (lane >> 3) + 8 * j; const LAS float* s = scr + (8 * c) * 33 + n; const float inv = 127.0f / fmaxf(wmax[src_col0 + n], 1e-30f);
        int qv[8];
#pragma unroll
        for (int e = 0; e < 8; ++e) { int v = (int)rintf(s[e * 33] * inv); v = v > 127 ? 127 : (v < -127 ? -127 : v); qv[e] = v & 255; }
        u32x2 o; o.x = (unsigned)(qv[0] | (qv[1] << 8) | (qv[2] << 16) | (qv[3] << 24)); o.y = (unsigned)(qv[4] | (qv[5] << 8) | (qv[6] << 16) | (qv[7] << 24));
        *(u32x2*)(WT + ((size_t)(k0 >> 7) * nrows + dst_row0 + n) * 128 + (k0 & 127) + 8 * c) = o; }
    LDS_WAIT();
}
struct P0Item { const float* src; const float* wmx; unsigned char* dst; int ldw, dpitch, perm; };
__device__ __forceinline__ void p0_misc(const Args& a, LAS unsigned char* lds, int tid, int lane, int wave, int G) {
    asm volatile("" : "+v"(tid)); lane = tid & 63; wave = __builtin_amdgcn_readfirstlane(tid >> 6);
    unsigned char* ws = a.ws;
    LAS float* SC = (LAS float*)(lds + 69632);
    LAS float* RED = (LAS float*)(lds + 110592);
    {
    for (int i = tid; i < 5 * DM; i += NWAVES * 64) { const float v = i < 4 * DM ? a.in[IN_C][i] : a.in[IN_CCTX][i - 4 * DM]; SC[i] = v * sigmoid_f(v); }
    __syncthreads();
    float* MOD = (float*)(ws + WS_MOD);
    for (int it = blockIdx.x; it < 2 * 576; it += G) {
        const int l = it / 576, col0 = (it % 576) * 32;
        const float* wp = a.in[IN_WMOD] + (size_t)l * DM * MODW + col0 + (lane & 7) * 4;
        f32x4 acc[5];
#pragma unroll
        for (int b = 0; b < 5; ++b) acc[b] = (f32x4){0.f, 0.f, 0.f, 0.f};
        const int kb = wave * 256 + (lane >> 3);
#pragma unroll 8
        for (int i = 0; i < 32; ++i) { const int k = kb + i * 8; const f32x4 wv = *(const f32x4*)(wp + (size_t)k * MODW);
#pragma unroll
            for (int b = 0; b < 5; ++b) acc[b] += SC[b * DM + k] * wv; }
#pragma unroll
        for (int b = 0; b < 5; ++b)
#pragma unroll
            for (int j = 0; j < 4; ++j) { float v = acc[b][j]; v += swz_xor<8>(v); v += swz_xor<16>(v); v = half_sum(v); acc[b][j] = v; }
        if (lane < 8) {
#pragma unroll
            for (int b = 0; b < 5; ++b) *(LAS f32x4*)(RED + (wave * 5 + b) * 32 + lane * 4) = acc[b]; }
        __syncthreads();
        if (tid < 160) { const int b = tid >> 5, cc = tid & 31; float s = a.in[IN_BMOD][l * MODW + col0 + cc];
#pragma unroll
            for (int w = 0; w < 8; ++w) s += RED[(w * 5 + b) * 32 + cc];
            MOD[(size_t)(l * 5 + b) * MODW + col0 + cc] = s; }
        __syncthreads();
    }
    if (blockIdx.x == 0) {
        f32x2* ROPE = (f32x2*)(ws + WS_ROPE);
        for (int i = tid; i < 64 * 32; i += NWAVES * 64) { const int pos = i >> 5, f = i & 31;
            const float inv = exp2f(-(float)f * (13.287712379549449f / 32.0f)); const float ang = (float)pos * inv;
            const double rev = (double)ang * 0.15915494309189535; const float fr = (float)(rev - __builtin_rint(rev));
            ROPE[i] = (f32x2){__builtin_amdgcn_cosf(fr), __builtin_amdgcn_sinf(fr)}; }
        if (tid < 256) { const int hd = tid & 127, p = hd & 63; ((float*)(ws + WS_QKG))[tid] = (tid < 128 ? a.in[IN_AQN] : a.in[IN_AKN])[(hd & 64) + (p & 1) * 32 + (p >> 1)]; }
    }
    }
}
constexpr int P0_I_FI = 32 * 344, P0_I_FO = 86 * 64, P0_I_ABI = 32 * 112, P0_I_ABO = 32 * 64, P0_I_NAI = 32 * 192, P0_I_NAO = 32 * 64, P0_I_LRU = 32 * 8;
__host__ __device__ constexpr int p0_nitems(int set) { return set < 0 ? P0_I_ABI + P0_I_ABO + P0_I_LRU : (set < 4 ? P0_I_FI + P0_I_FO : P0_I_NAI + P0_I_NAO); }
__device__ __forceinline__ void p0_convert(const Args& a, LAS unsigned char* lds, int tid, int vc, int VG, int set, int lo, int hi) {
    asm volatile("" : "+v"(tid)); const int lane = tid & 63, wave = __builtin_amdgcn_readfirstlane(tid >> 6);
    unsigned char* ws = a.ws;
    LAS float* scr = (LAS float*)(lds + wave * 8704);
    constexpr int I_FI = P0_I_FI, I_ABI = P0_I_ABI, I_ABO = P0_I_ABO, I_NAI = P0_I_NAI;
    const int gw = lo + vc * NWAVES + wave, NGW = VG * NWAVES, nloc = hi;
    if (set >= 0 && set < 4 && hi > I_FI) {
        unsigned char* z = ws + WS_WFO + (size_t)set * DM * HQP + FF;
        u32x4 z0 = (u32x4){0u, 0u, 0u, 0u}; asm volatile("" : "+v"(z0));
        for (int i = vc * (NWAVES * 64) + tid; i < DM * 8; i += VG * NWAVES * 64) *(u32x4*)(z + (size_t)(i >> 3) * HQP + (i & 7) * 16) = z0; }
    if (gw < nloc) {
        const float* dummy = (const float*)(ws + WS_CTL);
        auto decode = [&](int il, P0Item& d) {
            d.perm = 0;
            if (set < 0) {
                if (il < I_ABI) { const int kb = il / 112, nb = il % 112; d.src = a.in[IN_ABWI] + (size_t)kb * 64 * ABN + nb * 32; d.ldw = ABN; d.dst = ws + WS_WABI + ((size_t)nb * 32 * DM + kb * 64) * 2; d.dpitch = DM * 2;
                    if (nb >= 64 && nb < 104) { const int w = nb & 3; d.perm = 1; d.src = a.in[IN_ABWI] + (size_t)kb * 64 * ABN + (nb & ~3) * 32 + (w >> 1) * 64 + (w & 1) * 16; } }
                else if (il < I_ABI + I_ABO) { const int r = il - I_ABI, kb = r / 64, nb = r % 64; d.src = a.in[IN_ABWO] + (size_t)kb * 64 * DM + nb * 32; d.ldw = DM; d.dst = ws + WS_WABO + ((size_t)nb * 32 * DM + kb * 64) * 2; d.dpitch = DM * 2; }
                else { const int r = il - I_ABI - I_ABO, mm = r >> 3, qq = r & 7, which = mm >> 4, dir = (mm >> 3) & 1, blk = mm & 7, kb = qq >> 2, nb = qq & 3;
                    d.src = (which ? a.in[IN_LWX] : a.in[IN_LWA]) + (size_t)(dir * 8 + blk) * 128 * 128 + kb * 64 * 128 + nb * 32; d.ldw = 128;
                    d.dst = ws + WS_WLRU + ((size_t)((dir * 2 + which) * 8 + blk) * 128 * 128 + nb * 32 * 128 + kb * 64) * 2; d.dpitch = 256; }
                d.wmx = dummy;
            } else if (set < 4) {
                if (il < I_FI) { const int kb = il / 344, nb = il % 344, R0 = nb * 32, tile = R0 >> 8, wi = R0 & 255, sc0 = wi < 128 ? tile * 128 + wi : FF + tile * 128 + (wi - 128);
                    d.src = a.in[IN_FWI] + (size_t)set * DM * FF2 + (size_t)kb * 64 * FF2 + sc0; d.ldw = FF2; d.wmx = (const float*)(ws + WS_CTL + CTL_WMAX_IN) + set * FF2 + sc0;
                    d.dst = ws + WS_WFI + (size_t)set * FF2 * DM + (size_t)R0 * DM + kb * 64; d.dpitch = DM; }
                else { const int r = il - I_FI, kb = r / 64, nb = r % 64;
                    d.src = a.in[IN_FWO] + (size_t)set * FF * DM + (size_t)kb * 64 * DM + nb * 32; d.ldw = DM; d.wmx = (const float*)(ws + WS_CTL + CTL_WMAX_OUT) + set * DM + nb * 32;
                    d.dst = ws + WS_WFO + (size_t)set * DM * HQP + (size_t)(nb * 32) * HQP + kb * 64; d.dpitch = HQP; }
            } else {
                if (il < I_NAI) { const int kb = il / 192, nb = il % 192; d.src = a.in[IN_NAWI] + (size_t)kb * 64 * NAN3 + nb * 32; d.ldw = NAN3; d.wmx = (const float*)(ws + WS_CTL + CTL_WMAX_NAI) + nb * 32;
                    d.dst = ws + WS_WNAI + (size_t)nb * 32 * DM + kb * 64; d.dpitch = DM; }
                else { const int r = il - I_NAI, kb = r / 64, nb = r % 64; d.src = a.in[IN_NAWO] + (size_t)kb * 64 * DM + nb * 32; d.ldw = DM; d.wmx = (const float*)(ws + WS_CTL + CTL_WMAX_NAO) + nb * 32;
                    d.dst = ws + WS_WNAO + (size_t)nb * 32 * DM + kb * 64; d.dpitch = DM; }
            }
        };
        const int lr = lane >> 3, lc = lane & 7;
        auto issue = [&](const P0Item& d, f32x4 (&t)[8], float (&wm)[4]) {
            const float* sp = d.src + (size_t)lr * d.ldw + (d.perm ? 4 * (lc & 3) + 32 * (lc >> 2) : 4 * lc);
#pragma unroll
            for (int i = 0; i < 8; ++i) t[i] = *(const f32x4*)(sp + (size_t)(8 * i) * d.ldw);
#pragma unroll
            for (int j = 0; j < 4; ++j) wm[j] = d.wmx[lr + 8 * j];
        };
        auto process = [&](const P0Item& d, const f32x4 (&t)[8], const float (&wm)[4]) {
            { LAS float* sp = scr + lr * 33 + 4 * lc;
#pragma unroll
              for (int i = 0; i < 8; ++i) { sp[(8 * i) * 33 + 0] = t[i].x; sp[(8 * i) * 33 + 1] = t[i].y; sp[(8 * i) * 33 + 2] = t[i].z; sp[(8 * i) * 33 + 3] = t[i].w; } }
            LDS_WAIT();
            const LAS float* s0 = scr + (8 * lc) * 33 + lr;
            if (set < 0) {
#pragma unroll
                for (int j = 0; j < 4; ++j) { const LAS float* s = s0 + 8 * j;
                    u32x4 o; o.x = cvtpk(s[0 * 33], s[1 * 33]); o.y = cvtpk(s[2 * 33], s[3 * 33]); o.z = cvtpk(s[4 * 33], s[5 * 33]); o.w = cvtpk(s[6 * 33], s[7 * 33]);
                    const int n = lr + 8 * j, nd = d.perm ? 2 * (n & 15) + (n >> 4) : n;
                    *(u32x4*)(d.dst + (size_t)nd * d.dpitch + 16 * lc) = o; }
            } else {
#pragma unroll
                for (int j = 0; j < 4; ++j) { const LAS float* s = s0 + 8 * j; const float inv = 127.0f / fmaxf(wm[j], 1e-30f);
                    u32x2 o; o.x = pack_i8x4((f32x4){s[0 * 33], s[1 * 33], s[2 * 33], s[3 * 33]}, inv); o.y = pack_i8x4((f32x4){s[4 * 33], s[5 * 33], s[6 * 33], s[7 * 33]}, inv);
                    *(u32x2*)(d.dst + (size_t)(lr + 8 * j) * d.dpitch + 8 * lc) = o; }
            }
            LDS_WAIT();
        };
        int il = gw; P0Item dA, dB; f32x4 tA[8], tB[8]; float wA[4], wB[4];
        decode(il, dA); issue(dA, tA, wA);
        for (;;) {
            const int ilb = il + NGW; const bool moreB = ilb < nloc;
            decode(moreB ? ilb : il, dB); issue(dB, tB, wB);
            process(dA, tA, wA);
            if (!moreB) break;
            il = ilb + NGW; const bool moreA = il < nloc;
            decode(moreA ? il : ilb, dA); issue(dA, tA, wA);
            process(dB, tB, wB);
            if (!moreA) break;
        }
    }
}

__device__ __forceinline__ void norm_phase(const void* src_lat, bool lat_bf, const void* src_ctx, bool ctx_bf, bf16* H, const float* g, const float* modl  ,
                                           int shift_idx, int scale_idx, int nrows, int tid, int G, const bf16* dlat, const bf16* part, const float* pgate, float pgs, bf16* xcopy  , bf16* xw_ctx, signed char* H8, float* rowscale) {
    asm volatile("" : "+v"(tid)); const int lane = tid & 63, wave = __builtin_amdgcn_readfirstlane(tid >> 6), gw = blockIdx.x * NWAVES + wave, NGW = G * NWAVES;
    int cur = -1; f32x4 gs[8], sh[8], pg[8];
    const bool rebal = part != nullptr && NGW == 2048 && nrows == MT;
    auto row_at = [&](int k) -> int {
        if (!rebal) { const int r = gw + k * NGW; return r < nrows ? r : -1; }
        if (gw < 1024) return k == 0 ? ML + gw : (k <= NORM_LA ? gw + 1024 * (k - 1) : -1);
        return k < 16 - NORM_LA ? 1024 * NORM_LA + (gw - 1024) + 1024 * k : -1; };
    for (int k = 0;; ++k) { const int row = row_at(k); if (row < 0) break;
        const int slot = row < ML ? (row >> 12) : 4;
        if (slot != cur) { cur = slot;
            const f32x4* g4 = (const f32x4*)g + lane; const f32x4* sc4 = (const f32x4*)(modl + (size_t)(slot * 9 + scale_idx) * DM) + lane; const f32x4* sh4 = (const f32x4*)(modl + (size_t)(slot * 9 + shift_idx) * DM) + lane;
#pragma unroll
            for (int j = 0; j < 8; ++j) { gs[j] = g4[64 * j] * (sc4[64 * j] + 1.0f); sh[j] = sh4[64 * j]; }
            if (dlat != nullptr || part != nullptr) { const f32x4* pg4 = (const f32x4*)(pgate + (size_t)slot * (9 * DM)) + lane;
#pragma unroll
                for (int j = 0; j < 8; ++j) pg[j] = pg4[64 * j] * pgs; } }
        f32x4 v[8]; float ss = 0.f;
        { const bool isl = row < ML; const void* sp = isl ? src_lat : src_ctx; const size_t ro = (size_t)(isl ? row : row - ML) * DM;
          if (isl ? lat_bf : ctx_bf) { const u32x2* xb = (const u32x2*)((const bf16*)sp + ro) + lane; u32x2 w[8];
#pragma unroll
              for (int j = 0; j < 8; ++j) w[j] = xb[64 * j];
#pragma unroll
              for (int j = 0; j < 8; ++j) v[j] = (f32x4){bflo(w[j].x), bfhi(w[j].x), bflo(w[j].y), bfhi(w[j].y)}; }
          else { const f32x4* xr = (const f32x4*)((const float*)sp + ro) + lane;
#pragma unroll
              for (int j = 0; j < 8; ++j) v[j] = xr[64 * j]; } }
        if (row < ML) { if (xcopy != nullptr) { u32x2* xw = (u32x2*)(xcopy + (size_t)row * DM) + lane;
#pragma unroll
                for (int j = 0; j < 8; ++j) { u32x2 xo; xo.x = cvtpk(v[j].x, v[j].y); xo.y = cvtpk(v[j].z, v[j].w); xw[64 * j] = xo; } } }
        else if (part != nullptr) { const u32x2* pr = (const u32x2*)(part + (size_t)(row - ML) * DM) + lane; u32x2* xw = (u32x2*)(xw_ctx + (size_t)(row - ML) * DM) + lane;
#pragma unroll
            for (int j = 0; j < 8; ++j) { u32x2 pw[8];
#pragma unroll
                for (int p = 0; p < 8; ++p) pw[p] = pr[(size_t)p * (MC * DM / 4) + 64 * j];
                f32x4 sp = (f32x4){0.f, 0.f, 0.f, 0.f};
#pragma unroll
                for (int p = 0; p < 8; ++p) sp += (f32x4){bflo(pw[p].x), bfhi(pw[p].x), bflo(pw[p].y), bfhi(pw[p].y)};
                v[j] += pg[j] * sp; u32x2 xo; xo.x = cvtpk(v[j].x, v[j].y); xo.y = cvtpk(v[j].z, v[j].w); xw[64 * j] = xo; } }
#pragma unroll
        for (int j = 0; j < 8; ++j) ss += (v[j].x * v[j].x + v[j].y * v[j].y) + (v[j].z * v[j].z + v[j].w * v[j].w);
        const float rs = 1.0f / sqrtf(wave_sum(ss) * (1.0f / DM) + EPSN);
        if (H8 != nullptr) { float am = 0.f;
#pragma unroll
            for (int j = 0; j < 8; ++j) { v[j] = v[j] * rs * gs[j] + sh[j]; am = fmaxf(fmaxf(am, fmaxf(fabsf(v[j].x), fabsf(v[j].y))), fmaxf(fabsf(v[j].z), fabsf(v[j].w))); }
            am = fmaxf(wave_max(am), 1e-30f); const float inv = 127.0f / am; unsigned* o4 = (unsigned*)(H8 + (size_t)row * DM) + lane;
#pragma unroll
            for (int j = 0; j < 8; ++j) o4[64 * j] = pack_i8x4(v[j], inv);
            if (lane == 0) rowscale[row] = am * (1.0f / 127.0f); }
        else { u32x2* o8 = (u32x2*)(H + (size_t)row * DM) + lane;
#pragma unroll
            for (int j = 0; j < 8; ++j) { const f32x4 y = v[j] * rs * gs[j] + sh[j]; u32x2 w; w.x = cvtpk(y.x, y.y); w.y = cvtpk(y.z, y.w); o8[64 * j] = w; } }
    }
}

#define SBAR() __builtin_amdgcn_sched_barrier(0)
__device__ __forceinline__ void hidden_quant_phase(const bf16* Hb, signed char* H8, float* rowscale, int nrows, int tid, int G) {
    asm volatile("" : "+v"(tid)); const int lane = tid & 63, wave = __builtin_amdgcn_readfirstlane(tid >> 6);
    const int ch = lane >> 3, sub = lane & 7;
    for (int row = blockIdx.x * NWAVES + wave; row < nrows; row += G * NWAVES) {
        u32x4 w[11]; float am = 0.f;
#pragma unroll
        for (int i = 0; i < 11; ++i) { const int c = 8 * i + ch; w[i] = (c < 86) ? *(const u32x4*)(Hb + (size_t)row * FF + c * 64 + sub * 8) : (u32x4){0u, 0u, 0u, 0u}; }
        SBAR();
#pragma unroll
        for (int i = 0; i < 11; ++i) { float x[8]; unpack8(w[i], x);
#pragma unroll
            for (int e = 0; e < 8; ++e) am = fmaxf(am, fabsf(x[e])); }
        am = fmaxf(wave_max(am) * HID_CLIP, 1e-30f); const float inv = 127.0f / am;
#pragma unroll
        for (int i = 0; i < 11; ++i) { const int c = 8 * i + ch; float x[8]; unpack8(w[i], x);
            u32x2 o; o.x = pack_i8x4((f32x4){x[0], x[1], x[2], x[3]}, inv); o.y = pack_i8x4((f32x4){x[4], x[5], x[6], x[7]}, inv);
            if (c < 88) *(u32x2*)(H8 + (size_t)row * HQP + c * 64 + sub * 8) = o; }
        if (lane == 0) rowscale[row] = am * (1.0f / 127.0f);
    }
}

__device__ __forceinline__ void row_quant_phase(const bf16* Yb, signed char* Y8, float* rowscale, int nrows, int tid, int G) {
    asm volatile("" : "+v"(tid)); const int lane = tid & 63, wave = __builtin_amdgcn_readfirstlane(tid >> 6);
    for (int row = blockIdx.x * NWAVES + wave; row < nrows; row += G * NWAVES) {
        u32x4 w[4]; float am = 0.f;
#pragma unroll
        for (int i = 0; i < 4; ++i) w[i] = *(const u32x4*)(Yb + (size_t)row * DM + (lane + 64 * i) * 8);
#pragma unroll
        for (int i = 0; i < 4; ++i) { float x[8]; unpack8(w[i], x);
#pragma unroll
            for (int e = 0; e < 8; ++e) am = fmaxf(am, fabsf(x[e])); }
        am = fmaxf(wave_max(am), 1e-30f); const float inv = 127.0f / am;
#pragma unroll
        for (int i = 0; i < 4; ++i) { float x[8]; unpack8(w[i], x); u32x2 o; o.x = pack_i8x4((f32x4){x[0], x[1], x[2], x[3]}, inv); o.y = pack_i8x4((f32x4){x[4], x[5], x[6], x[7]}, inv);
            *(u32x2*)(Y8 + (size_t)row * DM + (lane + 64 * i) * 8) = o; }
        if (lane == 0) rowscale[row] = am * (1.0f / 127.0f);
    }
}

template <int CTRL> __device__ __forceinline__ float dpp_mov(float oldv, float src) { return __int_as_float(__builtin_amdgcn_update_dpp(__float_as_int(oldv), __float_as_int(src), CTRL, 0xF, 0xF, false)); }
__device__ __forceinline__ float lane_bcast(int byte_addr, float v) { return __int_as_float(__builtin_amdgcn_ds_bpermute(byte_addr, __float_as_int(v))); }
template <bool REV> __device__ __forceinline__ void row_scan(float& a, float& b) {
#define LRU_STEP(D) do { const float ap = REV ? dpp_mov<0x100 + D>(1.0f, a) : dpp_mov<0x110 + D>(1.0f, a); const float bp = REV ? dpp_mov<0x100 + D>(0.0f, b) : dpp_mov<0x110 + D>(0.0f, b); b = fmaf(a, bp, b); a = a * ap; } while (0)
    LRU_STEP(1); LRU_STEP(2); LRU_STEP(4); LRU_STEP(8);
#undef LRU_STEP
}
struct LruConvRegs { u32x4 xv[2][4]; };
__device__ __forceinline__ void lru_unit_coords(int u, int& n, int& j, int& b, int& Lseg, int& t0, size_t& rowbase) {
    n = u & 7; j = (u >> 3) % 68; b = u / 544; const bool isctx = j < 4; Lseg = isctx ? CTXL : SEQL; t0 = isctx ? 64 * j : 64 * (j - 4); rowbase = isctx ? (size_t)(ML + CTXL * b) : (size_t)(SEQL * b);
}
__device__ __forceinline__ void lru_conv_load(LruConvRegs& R, const bf16* P, int u, int tid) {
    asm volatile("" : "+v"(tid));
    int n, j, b, Lseg, t0; size_t rowbase; lru_unit_coords(u, n, j, b, Lseg, t0, rowbase); const int c8 = (tid & 15) * 8;
#pragma unroll
    for (int pass = 0; pass < 2; ++pass)
#pragma unroll
        for (int k = 0; k < 4; ++k) { int ts = t0 + pass * 32 + (tid >> 4) + k - 2; ts = ts < 0 ? 0 : (ts > Lseg - 1 ? Lseg - 1 : ts); R.xv[pass][k] = *(const u32x4*)(P + (rowbase + ts) * ABN + 128 * n + c8); }
}
template <bool FINAL>
__device__ __forceinline__ void lru_phase(const Args& a, LAS unsigned char* lds, int tid, int lane, int wave, int G, int vc = -1, int VG = 1, int NA = 0) {
    asm volatile("" : "+v"(tid)); lane = tid & 63; wave = __builtin_amdgcn_readfirstlane(tid >> 6);
    unsigned char* ws = a.ws;
    const bf16* P = (const bf16*)(ws + WS_BIG); bf16* Y = (bf16*)(ws + WS_H); f32x2* CARRY = (f32x2*)(ws + WS_CARRY); const float* HIN = (const float*)(ws + WS_HIN); const bf16* WL = (const bf16*)(ws + WS_WLRU);
    LAS unsigned char* U = lds + LRU_U_OFF;
    LAS unsigned char* WR = lds + wave * 16384 + lane * 16;
    const int l15 = lane & 15, l4 = lane >> 4, c8 = (tid & 15) * 8;
    const int bc_last = ((lane & ~15) + 15) * 4, bc_first = (lane & ~15) * 4;
    int cur_n = -1;
    LAS f32x4* PRM = (LAS f32x4*)(lds + LRU_U_OFF + 17408) + wave * 24 + l4;
    LruConvRegs CR;
    constexpr int NU = 4 * 68 * 8;
    const int kA = (vc >= 0 && vc < NA) ? (NA - vc + VG - 1) / VG : 0;
    auto unit_at = [&](int k) -> int { return k < kA ? vc + k * VG : NA + (int)blockIdx.x + (k - kA) * G; };
    if (unit_at(0) < NU) lru_conv_load(CR, P, unit_at(0), tid);
    for (int k = 0;; ++k) { const int u = unit_at(k); if (u >= NU) break;
        int n, j, b, Lseg, t0; size_t rowbase; lru_unit_coords(u, n, j, b, Lseg, t0, rowbase);
        if (n != cur_n) { cur_n = n; int l15x = l15; asm volatile("" : "+v"(l15x));
#pragma unroll
            for (int dir = 0; dir < 2; ++dir)
#pragma unroll
                for (int gt = 0; gt < 2; ++gt)
#pragma unroll
                    for (int ks = 0; ks < 4; ++ks) *(LAS bf16x8*)(WR + ((dir * 2 + gt) * 4 + ks) * 1024) = *(const bf16x8*)(WL + ((size_t)(((dir * 2 + gt) * 8 + n) * 128 + 16 * wave + l15x)) * 128 + 32 * ks + 8 * l4);
            int l4x = l4; asm volatile("" : "+v"(l4x));
#pragma unroll
            for (int dir = 0; dir < 2; ++dir) { const int ch = dir * 1024 + 128 * n + 16 * wave + 4 * l4x; const f32x4 bav = *(const f32x4*)(a.in[IN_LBA] + ch), bxv = *(const f32x4*)(a.in[IN_LBX] + ch), lmv = *(const f32x4*)(a.in[IN_LAM] + ch);
                f32x4 spv;
#pragma unroll
                for (int jj = 0; jj < 4; ++jj) { const float lm = -lmv[jj]; spv[jj] = (fmaxf(lm, 0.f) + log1pf(expf(-fabsf(lm)))) * (-8.0f * 1.4426950408889634f); }
                PRM[(dir * 3 + 0) * 4] = bav; PRM[(dir * 3 + 1) * 4] = bxv; PRM[(dir * 3 + 2) * 4] = spv; }
        }
        { float y[2][8]; const float* cwp = a.in[IN_CONVW] + 128 * n + c8; const float* cbp = a.in[IN_CONVB] + 128 * n + c8;
          f32x4 w0[4], w1[4]; const f32x4 b0 = *(const f32x4*)cbp, b1 = *(const f32x4*)(cbp + 4);
#pragma unroll
          for (int k = 0; k < 4; ++k) { w0[k] = *(const f32x4*)(cwp + k * 1024); w1[k] = *(const f32x4*)(cwp + k * 1024 + 4); }
          SBAR();
#pragma unroll
          for (int pass = 0; pass < 2; ++pass) {
#pragma unroll
            for (int e = 0; e < 4; ++e) { y[pass][e] = b0[e]; y[pass][4 + e] = b1[e]; }
#pragma unroll
            for (int k = 0; k < 4; ++k) { const int ts = t0 + pass * 32 + (tid >> 4) + k - 2; const float msk = (ts >= 0 && ts < Lseg) ? 1.0f : 0.0f; float x[8]; unpack8(CR.xv[pass][k], x);
#pragma unroll
                for (int e = 0; e < 4; ++e) { y[pass][e] = fmaf(x[e] * msk, w0[k][e], y[pass][e]); y[pass][4 + e] = fmaf(x[4 + e] * msk, w1[k][e], y[pass][4 + e]); } }
            *(LAS u32x4*)(U + (pass * 32 + (tid >> 4)) * 272 + c8 * 2) = pack8(y[pass]); } }
        LDS_BARRIER();
        { const int un = unit_at(k + 1); if (un < NU) lru_conv_load(CR, P, un, tid); }
        f32x4 hin[2];
        if (FINAL) {
#pragma unroll
            for (int dir = 0; dir < 2; ++dir) hin[dir] = *(const f32x4*)(HIN + (size_t)(((b * 2 + dir) * 68 + j)) * 1024 + 128 * n + 16 * wave + 4 * l4);
        }
        f32x4 hsum[4];
#pragma unroll
        for (int dir = 0; dir < 2; ++dir) {
            f32x4 acc[2][4]; bf16x8 wf[2][4];
#pragma unroll
            for (int gt = 0; gt < 2; ++gt)
#pragma unroll
                for (int ks = 0; ks < 4; ++ks) wf[gt][ks] = *(const LAS bf16x8*)(WR + ((dir * 2 + gt) * 4 + ks) * 1024);
#pragma unroll
            for (int mt = 0; mt < 4; ++mt) { bf16x8 uf[4];
#pragma unroll
                for (int ks = 0; ks < 4; ++ks) uf[ks] = *(const LAS bf16x8*)(U + (16 * mt + l15) * 272 + (32 * ks + 8 * l4) * 2);
#pragma unroll
                for (int gt = 0; gt < 2; ++gt) { f32x4 c4 = (f32x4){0.f, 0.f, 0.f, 0.f};
#pragma unroll
                    for (int ks = 0; ks < 4; ++ks) c4 = __builtin_amdgcn_mfma_f32_16x16x32_bf16(wf[gt][ks], uf[ks], c4, 0, 0, 0);
                    acc[gt][mt] = c4; } }
            f32x4 av[4], bv[4]; const f32x4 ba = PRM[(dir * 3 + 0) * 4], bx = PRM[(dir * 3 + 1) * 4], sp = PRM[(dir * 3 + 2) * 4];
#pragma unroll
            for (int mt = 0; mt < 4; ++mt) { const u32x2 uw = *(const LAS u32x2*)(U + (16 * mt + l15) * 272 + (16 * wave + 4 * l4) * 2);
                const float uu[4] = {bflo(uw.x), bfhi(uw.x), bflo(uw.y), bfhi(uw.y)};
#pragma unroll
                for (int jj = 0; jj < 4; ++jj) { const float r = sigmoid_f(acc[0][mt][jj] + ba[jj]), ig = sigmoid_f(acc[1][mt][jj] + bx[jj]);
                    const float aa = __builtin_amdgcn_exp2f(r * sp[jj]);
                    av[mt][jj] = aa; bv[mt][jj] = sqrtf(fmaxf(1.0f - aa * aa, 0.f)) * (ig * uu[jj]); } }
#pragma unroll
            for (int jj = 0; jj < 4; ++jj) { float cA = 1.0f, cH = FINAL ? hin[dir][jj] : 0.0f;
#pragma unroll
                for (int q = 0; q < 4; ++q) { const int mt = dir == 0 ? q : 3 - q; float aa = av[mt][jj], hh = bv[mt][jj];
                    if (dir == 0) row_scan<false>(aa, hh); else row_scan<true>(aa, hh);
                    hh = fmaf(aa, cH, hh);
                    if (q < 3 || !FINAL) { if (!FINAL) cA = lane_bcast(dir == 0 ? bc_last : bc_first, aa * cA); cH = lane_bcast(dir == 0 ? bc_last : bc_first, hh); }
                    if (FINAL) { if (dir == 0) hsum[mt][jj] = hh; else hsum[mt][jj] += hh; } }
                if (!FINAL) { av[0][jj] = cA; bv[0][jj] = cH; } }
            if (!FINAL) { if (l15 == 0) { f32x2* cr = CARRY + (size_t)((b * 2 + dir) * 68 + j) * 1024 + 128 * n + 16 * wave + 4 * l4;
#pragma unroll
                for (int jj = 0; jj < 4; ++jj) cr[jj] = (f32x2){av[0][jj], bv[0][jj]}; } }
        }
        if (FINAL) {
            u32x2 glw[4];
#pragma unroll
            for (int mt = 0; mt < 4; ++mt) glw[mt] = *(const u32x2*)(P + (rowbase + t0 + 16 * mt + l15) * ABN + 1024 + 128 * n + 16 * wave + 4 * l4);
            SBAR();
#pragma unroll
            for (int mt = 0; mt < 4; ++mt) { const float gl[4] = {bflo(glw[mt].x), bfhi(glw[mt].x), bflo(glw[mt].y), bfhi(glw[mt].y)}; float o[4];
#pragma unroll
                for (int jj = 0; jj < 4; ++jj) { const float x = gl[jj]; const float z2 = 1.5957691216057308f * (x + 0.044715f * x * x * x); o[jj] = hsum[mt][jj] * (x * sigmoid_f(z2)); }
                u32x2 w; w.x = cvtpk(o[0], o[1]); w.y = cvtpk(o[2], o[3]);
                *(u32x2*)(Y + (rowbase + t0 + 16 * mt + l15) * DM + 128 * n + 16 * wave + 4 * l4) = w; }
        }
        LDS_BARRIER();
    }
    __syncthreads();
}
__device__ __forceinline__ void lru_carry_scan(const Args& a, int tid, int G) {
    asm volatile("" : "+v"(tid));
    const f32x2* CARRY = (const f32x2*)(a.ws + WS_CARRY); float* HIN = (float*)(a.ws + WS_HIN);
    for (int id = blockIdx.x * (NWAVES * 64) + tid; id < 4 * 2 * 1024; id += G * (NWAVES * 64)) {
        const int c = id & 1023, dir = (id >> 10) & 1, b = id >> 11; const f32x2* cr = CARRY + (size_t)((b * 2 + dir) * 68) * 1024 + c; float* hp = HIN + (size_t)((b * 2 + dir) * 68) * 1024 + c; float h = 0.f;
        for (int q0 = 0; q0 < 68; q0 += 17) { f32x2 ce[17];
#pragma unroll
            for (int i = 0; i < 17; ++i) { const int q = q0 + i; const int jx = dir == 0 ? q : (q < 4 ? 3 - q : 71 - q); ce[i] = cr[(size_t)jx * 1024]; }
            SBAR();
#pragma unroll
            for (int i = 0; i < 17; ++i) { const int q = q0 + i; const int jx = dir == 0 ? q : (q < 4 ? 3 - q : 71 - q); hp[(size_t)jx * 1024] = h; h = fmaf(ce[i].x, h, ce[i].y); } }
    }
}

#define KSWZ(row, colB) ((row) * 256 + ((colB) ^ (((row) & 7) << 4)))
constexpr int AT_V = 0, AT_K = 16384, AT_BUF = 32768, AT_WS = 65536, AT_RPB = 67584, AT_ROPE = 67584, AT_OST = 83968;
constexpr float AT_THR = 8.f;
__device__ __forceinline__ int crow(int r, int hi) { return (r & 3) + 8 * (r >> 2) + 4 * hi; }
__device__ __forceinline__ void partialSM(f32x16& p0, f32x16& p1, float& m_reg, float& mn, float& alpha) {
    constexpr float C = ATT_SCALE * 1.4426950408889634f;
    float pmax = p0[0];
#pragma unroll
    for (int r = 1; r < 16; ++r) pmax = fmaxf(pmax, p0[r]);
#pragma unroll
    for (int r = 0; r < 16; ++r) pmax = fmaxf(pmax, p1[r]);
    { auto rr = __builtin_amdgcn_permlane32_swap(__float_as_uint(pmax), __float_as_uint(pmax), false, false); pmax = fmaxf(__uint_as_float(rr[0]), __uint_as_float(rr[1])); }
    if (__builtin_expect(__all(pmax - m_reg <= AT_THR / ATT_SCALE), 1)) { mn = m_reg; alpha = 1.f; }
    else { mn = fmaxf(m_reg, pmax); alpha = __builtin_amdgcn_exp2f((m_reg - mn) * C); m_reg = mn; }
    const float mnC = -mn * C;
#pragma unroll
    for (int r = 0; r < 16; ++r) p0[r] = __builtin_amdgcn_exp2f(fmaf(p0[r], C, mnC));
#pragma unroll
    for (int r = 0; r < 16; ++r) p1[r] = __builtin_amdgcn_exp2f(fmaf(p1[r], C, mnC));
}
__device__ __forceinline__ void finishSM(const f32x16& p0, const f32x16& p1, float alpha, float& l_reg, bf16x8& pa0, bf16x8& pa1, bf16x8& pa2, bf16x8& pa3) {
    float ps = 0.f;
#pragma unroll
    for (int r = 0; r < 16; ++r) ps += p0[r];
#pragma unroll
    for (int r = 0; r < 16; ++r) ps += p1[r];
    { auto rr = __builtin_amdgcn_permlane32_swap(__float_as_uint(ps), __float_as_uint(ps), false, false); ps = __uint_as_float(rr[0]) + __uint_as_float(rr[1]); }
    l_reg = l_reg * alpha + ps;
#define PK4(P, BASE, OUT) do { unsigned a0 = cvtpk(P[BASE + 0], P[BASE + 1]), a1 = cvtpk(P[BASE + 2], P[BASE + 3]);   \
    unsigned b0 = cvtpk(P[BASE + 4], P[BASE + 5]), b1 = cvtpk(P[BASE + 6], P[BASE + 7]);                              \
    auto r0 = __builtin_amdgcn_permlane32_swap(a0, b0, false, false); auto r1 = __builtin_amdgcn_permlane32_swap(a1, b1, false, false); \
    u32x4 w = {r0[0], r1[0], r0[1], r1[1]}; OUT = __builtin_bit_cast(bf16x8, w); } while (0)
    PK4(p0, 0, pa0); PK4(p0, 8, pa1); PK4(p1, 0, pa2); PK4(p1, 8, pa3);
#undef PK4
}
__device__ __forceinline__ void qkt(f32x16& p0, f32x16& p1, const LAS unsigned char* Ks, const bf16x8* qr, int r32, int hi) {
#pragma unroll
    for (int r = 0; r < 16; ++r) { p0[r] = 0.f; p1[r] = 0.f; }
#pragma unroll
    for (int d0 = 0; d0 < 8; ++d0) { const int cb = (d0 * 16 + hi * 8) * 2;
        const bf16x8 b0 = *(const LAS bf16x8*)(Ks + KSWZ(r32, cb)); const bf16x8 b1 = *(const LAS bf16x8*)(Ks + KSWZ(32 + r32, cb));
        p0 = __builtin_amdgcn_mfma_f32_32x32x16_bf16(b0, qr[d0], p0, 0, 0, 0); p1 = __builtin_amdgcn_mfma_f32_32x32x16_bf16(b1, qr[d0], p1, 0, 0, 0); }
}
__device__ __forceinline__ int v_st(int k, int c) { const int kk = (k & ~0xC) | ((k & 4) << 1) | ((k & 8) >> 1); return ((kk >> 3) * 4 + (c >> 5)) * 512 + ((kk & 7) * 32 + (c & 31)) * 2; }
__device__ __forceinline__ int v_rd_base(int lane) { return ((lane & 3) << 3) | (((lane >> 2) & 3) << 6) | (((lane >> 4) & 1) << 5) | (((lane >> 5) & 1) << 8); }
constexpr int v_rd_off(int d0, int ks, int half) { return d0 * 512 + ks * 4096 + half * 2048; }
template <int OFF> __device__ __forceinline__ s16x4 tr_read(int vb) { s16x4 r; asm volatile("ds_read_b64_tr_b16 %0, %1 offset:%2" : "=&v"(r) : "v"(vb), "i"(OFF) : "memory"); return r; }
template <int D0> __device__ __forceinline__ void pv_one(f32x16& od, int vb, bf16x8 pa0, bf16x8 pa1, bf16x8 pa2, bf16x8 pa3) {
    const s16x4 l0 = tr_read<v_rd_off(D0, 0, 0)>(vb), h0 = tr_read<v_rd_off(D0, 0, 1)>(vb), l1 = tr_read<v_rd_off(D0, 1, 0)>(vb), h1 = tr_read<v_rd_off(D0, 1, 1)>(vb);
    const s16x4 l2 = tr_read<v_rd_off(D0, 2, 0)>(vb), h2 = tr_read<v_rd_off(D0, 2, 1)>(vb), l3 = tr_read<v_rd_off(D0, 3, 0)>(vb), h3 = tr_read<v_rd_off(D0, 3, 1)>(vb);
    asm volatile("s_waitcnt lgkmcnt(0)" ::: "memory"); SBAR();
#define PKV(L, H) (bf16x8){L[0], L[1], L[2], L[3], H[0], H[1], H[2], H[3]}
    od = __builtin_amdgcn_mfma_f32_32x32x16_bf16(pa0, PKV(l0, h0), od, 0, 0, 0);
    od = __builtin_amdgcn_mfma_f32_32x32x16_bf16(pa1, PKV(l1, h1), od, 0, 0, 0);
    od = __builtin_amdgcn_mfma_f32_32x32x16_bf16(pa2, PKV(l2, h2), od, 0, 0, 0);
    od = __builtin_amdgcn_mfma_f32_32x32x16_bf16(pa3, PKV(l3, h3), od, 0, 0, 0);
#undef PKV
}
__device__ __forceinline__ void sm_pv(f32x16& p0, f32x16& p1, f32x16 (&o)[4], float& m_reg, float& l_reg, int vb, LAS float* al_l, int r32, int hi) {
    float mn, alpha; partialSM(p0, p1, m_reg, mn, alpha);
    if (__any(alpha < 1.f)) { if (hi == 0) al_l[r32] = alpha; LDS_WAIT();
#pragma unroll
        for (int d = 0; d < 4; ++d)
#pragma unroll
            for (int r = 0; r < 16; ++r) o[d][r] *= al_l[crow(r, hi)];
        LDS_WAIT(); }
    bf16x8 pa0, pa1, pa2, pa3; finishSM(p0, p1, alpha, l_reg, pa0, pa1, pa2, pa3); SBAR();
    pv_one<0>(o[0], vb, pa0, pa1, pa2, pa3); pv_one<1>(o[1], vb, pa0, pa1, pa2, pa3); pv_one<2>(o[2], vb, pa0, pa1, pa2, pa3); pv_one<3>(o[3], vb, pa0, pa1, pa2, pa3);
}
__device__ __forceinline__ void tile_prefetch(u32x4 (&kw)[2], u32x4 (&vw)[2], const bf16* Kb, const bf16* Vb, int ld, int tid) {
    const int sr = tid >> 4, sc = (tid & 15) * 8;
#pragma unroll
    for (int hh = 0; hh < 2; ++hh) { const int rr = sr + 32 * hh; kw[hh] = *(const u32x4*)(Kb + (size_t)rr * ld + sc); vw[hh] = *(const u32x4*)(Vb + (size_t)rr * ld + sc); }
}
__device__ __forceinline__ void tile_commit(const u32x4 (&kw)[2], const u32x4 (&vw)[2], const float* kg, bool rope, int ktok0, const LAS f32x2* ROPE, LAS unsigned char* lds, int boff, int tid) {
    asm volatile("" : "+v"(tid));
    const int sr = tid >> 4, sc = (tid & 15) * 8, l16 = tid & 15;
    float kgv[8]; { const f32x4 g0 = *(const f32x4*)(kg + sc), g1 = *(const f32x4*)(kg + sc + 4); kgv[0] = g0[0]; kgv[1] = g0[1]; kgv[2] = g0[2]; kgv[3] = g0[3]; kgv[4] = g1[0]; kgv[5] = g1[1]; kgv[6] = g1[2]; kgv[7] = g1[3]; }
#pragma unroll
    for (int hh = 0; hh < 2; ++hh) { const int rr = sr + 32 * hh; float y[8]; unpack8(kw[hh], y); float ss = 0.f;
#pragma unroll
        for (int e = 0; e < 8; ++e) ss += y[e] * y[e];
        ss += swz_xor<1>(ss); ss += swz_xor<2>(ss); ss += swz_xor<4>(ss); ss += swz_xor<8>(ss);
        const float rs = 1.0f / sqrtf(ss * (1.0f / 128.0f) + EPSN);
#pragma unroll
        for (int e = 0; e < 8; ++e) y[e] *= rs * kgv[e];
        if (rope) { const int tok = ktok0 + rr; const int pos = (l16 < 8) ? (tok >> 6) : (tok & 63); const LAS f32x2* rp = ROPE + pos * 32 + (l16 & 3) * 8; const float sg = (l16 & 4) ? 1.f : -1.f;
#pragma unroll
            for (int e = 0; e < 8; ++e) { const float pr = swz_xor<4>(y[e]); const f32x2 cs = rp[e]; y[e] = y[e] * cs.x + sg * pr * cs.y; } }
        *(LAS u32x4*)(lds + boff + AT_K + KSWZ(rr, sc * 2)) = pack8(y);
        *(LAS u32x4*)(lds + boff + AT_V + v_st(rr, sc)) = vw[hh]; }
}
__device__ __forceinline__ void tile_commit_plain(const u32x4 (&kw)[2], const u32x4 (&vw)[2], LAS unsigned char* lds, int boff, int tid) {
    asm volatile("" : "+v"(tid));
    const int sr = tid >> 4, sc = (tid & 15) * 8;
#pragma unroll
    for (int hh = 0; hh < 2; ++hh) { const int rr = sr + 32 * hh; *(LAS u32x4*)(lds + boff + AT_K + KSWZ(rr, sc * 2)) = kw[hh]; *(LAS u32x4*)(lds + boff + AT_V + v_st(rr, sc)) = vw[hh]; }
}
__device__ __forceinline__ void load_q_plain(bf16x8 (&qr)[8], const bf16* qp, int hi) {
#pragma unroll
    for (int d0 = 0; d0 < 8; ++d0) qr[d0] = __builtin_bit_cast(bf16x8, *(const u32x4*)(qp + d0 * 16 + hi * 8));
}
__device__ __forceinline__ void load_q(bf16x8 (&qr)[8], const bf16* qp  , const float* qg, bool rope, int qtok, const LAS f32x2* ROPE, int hi) {
    u32x4 w[8]; f32x4 g[16];
#pragma unroll
    for (int d0 = 0; d0 < 8; ++d0) w[d0] = *(const u32x4*)(qp + d0 * 16 + hi * 8);
#pragma unroll
    for (int d0 = 0; d0 < 8; ++d0) { g[2 * d0] = *(const f32x4*)(qg + d0 * 16 + hi * 8); g[2 * d0 + 1] = *(const f32x4*)(qg + d0 * 16 + hi * 8 + 4); }
    SBAR();
    float x[8][8]; float ss = 0.f;
#pragma unroll
    for (int d0 = 0; d0 < 8; ++d0) { unpack8(w[d0], x[d0]);
#pragma unroll
        for (int e = 0; e < 8; ++e) ss += x[d0][e] * x[d0][e]; }
    ss = half_sum(ss);
    const float rs = 1.0f / sqrtf(ss * (1.0f / 128.0f) + EPSN);
#pragma unroll
    for (int d0 = 0; d0 < 8; ++d0)
#pragma unroll
        for (int e = 0; e < 4; ++e) { x[d0][e] *= rs * g[2 * d0][e]; x[d0][4 + e] *= rs * g[2 * d0 + 1][e]; }
    if (rope) {
#pragma unroll
        for (int half = 0; half < 2; ++half) { const int pos = half ? (qtok & 63) : (qtok >> 6);
#pragma unroll
            for (int dd = 0; dd < 2; ++dd) { const int d0 = half * 4 + dd; const LAS f32x2* rp = ROPE + pos * 32 + dd * 16 + hi * 8;
#pragma unroll
                for (int e = 0; e < 8; ++e) { const f32x2 cs = rp[e]; const float x1 = x[d0][e], x2 = x[d0 + 2][e]; x[d0][e] = x1 * cs.x - x2 * cs.y; x[d0 + 2][e] = x2 * cs.x + x1 * cs.y; } } } }
#pragma unroll
    for (int d0 = 0; d0 < 8; ++d0) qr[d0] = __builtin_bit_cast(bf16x8, pack8(x[d0]));
}
__device__ __forceinline__ void store_o(const f32x16 (&o)[4], float l_reg, bf16* yb, LAS float* li_l, LAS unsigned char* ost, int lane, int hstep = 16) {
    int r32 = lane & 31, hi = lane >> 5;
    if (hi == 0) li_l[r32] = l_reg; LDS_WAIT();
    asm volatile("" : "+v"(hi));
    int l2 = lane; asm volatile("" : "+v"(l2));
#pragma unroll
    for (int p = 0; p < 2; ++p) {
#pragma unroll
        for (int r = 8 * p; r < 8 * p + 8; ++r) { const int orow = crow(r, hi); const float rl = __builtin_amdgcn_rcpf(li_l[orow]);
#pragma unroll
            for (int d0 = 0; d0 < 4; ++d0) *(LAS unsigned short*)(ost + (orow & 15) * 256 + (d0 * 32 + r32) * 2) = f2bf(o[d0][r] * rl); }
        LDS_WAIT();
#pragma unroll
        for (int i = 0; i < 4; ++i) { const int orow = 4 * i + (l2 >> 4), ch = l2 & 15; const u32x4 w = *(const LAS u32x4*)(ost + orow * 256 + ch * 16);
            *(u32x4*)(yb + (size_t)(p * hstep + orow) * DM + ch * 8) = w; }
        LDS_WAIT(); }
}

__device__ __forceinline__ void attn_ab_phase(const Args& a, LAS unsigned char* lds, int tid, int lane, int wave, int G) {
    asm volatile("" : "+v"(tid)); lane = tid & 63; wave = __builtin_amdgcn_readfirstlane(tid >> 6);
    unsigned char* ws = a.ws;
    const bf16* P = (const bf16*)(ws + WS_BIG); bf16* Y = (bf16*)(ws + WS_H);
    const int r32 = lane & 31, hi = lane >> 5;
    const int vb = (int)(uintptr_t)(lds + AT_V) + v_rd_base(lane);
    LAS float* wsf = (LAS float*)(lds + AT_WS) + wave * 64;
    for (int u = blockIdx.x; u < 544; u += G) {
        const bool lat = u < 512; const int v = u - 512;
        const int b = lat ? (u >> 7) : (v >> 3), kvh = lat ? ((u >> 6) & 1) : ((v >> 2) & 1), qb = lat ? (u & 63) : (v & 3);
        const int h = 4 * kvh + (wave >> 1), qi = 32 * (wave & 1) + r32, qtok = 64 * qb + qi;
        const size_t qrow = lat ? (size_t)(SEQL * b + qtok) : (size_t)(ML + CTXL * b + qtok);
        bf16x8 qr[8]; load_q_plain(qr, P + qrow * ABN + 2048 + h * 128, hi);
        float m_reg = a.in[IN_SINK][h] * (1.0f / ATT_SCALE), l_reg = 1.f;
        f32x16 o[4];
#pragma unroll
        for (int d = 0; d < 4; ++d)
#pragma unroll
            for (int r = 0; r < 16; ++r) o[d][r] = 0.f;
        const int kt_lo = lat ? (qb < 2 ? 2 - qb : 0) : 0, kt_hi = lat ? (qb > 61 ? 65 - qb : 4) : -1, nloc = kt_hi - kt_lo + 1, nt = nloc + 4;
        const bf16* Pk = P + 3072 + 128 * kvh; const size_t lrow0 = (size_t)(SEQL * b + 64 * qb - 128), crow0 = (size_t)(ML + CTXL * b);
        u32x4 kw[2], vw[2];
        __syncthreads();
        { const size_t kr0 = nloc > 0 ? lrow0 + 64 * kt_lo : crow0; tile_prefetch(kw, vw, Pk + kr0 * ABN, Pk + kr0 * ABN + 256, ABN, tid);
          tile_commit_plain(kw, vw, lds, 0, tid); }
        for (int ti = 0; ti < nt; ++ti) {
            const bool loc = ti < nloc; const int kt = kt_lo + ti; const int boff = (ti & 1) * AT_BUF;
            if (ti + 1 < nt) { const size_t kr1 = (ti + 1 < nloc) ? lrow0 + 64 * (kt + 1) : crow0 + 64 * (ti + 1 - nloc); tile_prefetch(kw, vw, Pk + kr1 * ABN, Pk + kr1 * ABN + 256, ABN, tid); }
            LDS_BARRIER();
            f32x16 p0, p1; qkt(p0, p1, lds + boff + AT_K, qr, r32, hi);
            int qim = qi; asm volatile("" : "+v"(qim));
            if (loc && kt == 0) {
#pragma unroll
                for (int r = 0; r < 16; ++r) { const int kk = crow(r, hi); p0[r] = (kk >= qim) ? p0[r] : -INFINITY; p1[r] = (kk + 32 >= qim) ? p1[r] : -INFINITY; } }
            if (loc && kt == 4) {
#pragma unroll
                for (int r = 0; r < 16; ++r) { const int kk = crow(r, hi); p0[r] = (kk <= qim) ? p0[r] : -INFINITY; p1[r] = (kk + 32 <= qim) ? p1[r] : -INFINITY; } }
            sm_pv(p0, p1, o, m_reg, l_reg, vb + boff, wsf + 32, r32, hi);
            if (ti + 1 < nt) tile_commit_plain(kw, vw, lds, AT_BUF - boff, tid);
        }
        const size_t orow0 = qrow - r32;
        store_o(o, l_reg, Y + orow0 * DM + 1024 + h * 128, wsf, lds + AT_OST + wave * 4096, lane);
    }
    __syncthreads();
}

__device__ __forceinline__ void qkt32(f32x16& p0, const LAS unsigned char* Ks  , const bf16x8* qr, const int (&ka)[8]) {
#pragma unroll
    for (int r = 0; r < 16; ++r) p0[r] = 0.f;
#pragma unroll
    for (int d0 = 0; d0 < 8; ++d0) { const bf16x8 b0 = *(const LAS bf16x8*)(Ks + ka[d0]); p0 = __builtin_amdgcn_mfma_f32_32x32x16_bf16(b0, qr[d0], p0, 0, 0, 0); }
}
__device__ __forceinline__ void qkt_ka(f32x16& p0, f32x16& p1, const LAS unsigned char* Ks, const bf16x8* qr, const int (&ka)[8]) {
#pragma unroll
    for (int r = 0; r < 16; ++r) { p0[r] = 0.f; p1[r] = 0.f; }
#pragma unroll
    for (int d0 = 0; d0 < 8; ++d0) { const bf16x8 b0 = *(const LAS bf16x8*)(Ks + ka[d0]); const bf16x8 b1 = *(const LAS bf16x8*)(Ks + ka[d0] + 32 * 256);
        p0 = __builtin_amdgcn_mfma_f32_32x32x16_bf16(b0, qr[d0], p0, 0, 0, 0); p1 = __builtin_amdgcn_mfma_f32_32x32x16_bf16(b1, qr[d0], p1, 0, 0, 0); }
}
__device__ __forceinline__ int v_rd_base_span(int lane, int cs) {
    const int common = ((lane & 3) << 3) | (((lane >> 2) & 3) << 6) | (((lane >> 4) & 1) << 5), L = (lane >> 5) & 1;
    return common + (cs >> 4) * 4096 + ((cs & 8) ? (L ? 4096 : 256) : (L ? 256 : 0));
}
template <int D0> __device__ __forceinline__ void pv_one32(f32x16& od, int vb, bf16x8 pa0, bf16x8 pa1) {
    const s16x4 l0 = tr_read<v_rd_off(D0, 0, 0)>(vb), h0 = tr_read<v_rd_off(D0, 0, 1)>(vb), l1 = tr_read<v_rd_off(D0, 1, 0)>(vb), h1 = tr_read<v_rd_off(D0, 1, 1)>(vb);
    asm volatile("s_waitcnt lgkmcnt(0)" ::: "memory"); SBAR();
#define PKV(L, H) (bf16x8){L[0], L[1], L[2], L[3], H[0], H[1], H[2], H[3]}
    od = __builtin_amdgcn_mfma_f32_32x32x16_bf16(pa0, PKV(l0, h0), od, 0, 0, 0);
    od = __builtin_amdgcn_mfma_f32_32x32x16_bf16(pa1, PKV(l1, h1), od, 0, 0, 0);
#undef PKV
}
__device__ __forceinline__ void sm_pv32(f32x16& p0, f32x16 (&o)[4], float& m_reg, float& l_reg, int vbs, LAS float* al_l, int r32, int hi) {
    constexpr float C = ATT_SCALE * 1.4426950408889634f;
    float pmax = p0[0];
#pragma unroll
    for (int r = 1; r < 16; ++r) pmax = fmaxf(pmax, p0[r]);
    { auto rr = __builtin_amdgcn_permlane32_swap(__float_as_uint(pmax), __float_as_uint(pmax), false, false); pmax = fmaxf(__uint_as_float(rr[0]), __uint_as_float(rr[1])); }
    float mn, alpha;
    if (__builtin_expect(__all(pmax - m_reg <= AT_THR / ATT_SCALE), 1)) { mn = m_reg; alpha = 1.f; }
    else { mn = fmaxf(m_reg, pmax); alpha = __builtin_amdgcn_exp2f((m_reg - mn) * C); m_reg = mn; }
    const float mnC = -mn * C; float ps = 0.f;
#pragma unroll
    for (int r = 0; r < 16; ++r) { p0[r] = __builtin_amdgcn_exp2f(fmaf(p0[r], C, mnC)); ps += p0[r]; }
    if (__any(alpha < 1.f)) { if (hi == 0) al_l[r32] = alpha; LDS_WAIT();
#pragma unroll
        for (int d = 0; d < 4; ++d)
#pragma unroll
            for (int r = 0; r < 16; ++r) o[d][r] *= al_l[crow(r, hi)];
        LDS_WAIT(); }
    { auto rr = __builtin_amdgcn_permlane32_swap(__float_as_uint(ps), __float_as_uint(ps), false, false); ps = __uint_as_float(rr[0]) + __uint_as_float(rr[1]); }
    l_reg = l_reg * alpha + ps;
    bf16x8 pa0, pa1;
#define PK4(P, BASE, OUT) do { unsigned a0 = cvtpk(P[BASE + 0], P[BASE + 1]), a1 = cvtpk(P[BASE + 2], P[BASE + 3]);   \
    unsigned b0 = cvtpk(P[BASE + 4], P[BASE + 5]), b1 = cvtpk(P[BASE + 6], P[BASE + 7]);                              \
    auto r0 = __builtin_amdgcn_permlane32_swap(a0, b0, false, false); auto r1 = __builtin_amdgcn_permlane32_swap(a1, b1, false, false); \
    u32x4 w = {r0[0], r1[0], r0[1], r1[1]}; OUT = __builtin_bit_cast(bf16x8, w); } while (0)
    PK4(p0, 0, pa0); PK4(p0, 8, pa1);
#undef PK4
    SBAR();
    pv_one32<0>(o[0], vbs, pa0, pa1); pv_one32<1>(o[1], vbs, pa0, pa1); pv_one32<2>(o[2], vbs, pa0, pa1); pv_one32<3>(o[3], vbs, pa0, pa1);
}

__device__ __forceinline__ void attn_na_phase(const Args& a, LAS unsigned char* lds, int tid, int lane, int wave, int G) {
    asm volatile("" : "+v"(tid)); lane = tid & 63; wave = __builtin_amdgcn_readfirstlane(tid >> 6);
    unsigned char* ws = a.ws;
    const bf16* Q = (const bf16*)(ws + WS_BIG); bf16* Y = (bf16*)(ws + WS_H);
    const int r32 = lane & 31, hi = lane >> 5;
    const int m = wave & 3, pr = wave >> 2, cs = m == 0 ? 0 : (m == 1 ? 8 : (m == 2 ? 24 : 32));
    const int vb = (int)(uintptr_t)(lds + AT_V) + v_rd_base(lane), vbs = (int)(uintptr_t)(lds + AT_V) + v_rd_base_span(lane, cs);
    LAS float* wsf = (LAS float*)(lds + AT_WS) + wave * 64;
    LAS float* RPB = (LAS float*)(lds + AT_RPB);
    int ka[8];
#pragma unroll
    for (int d0 = 0; d0 < 8; ++d0) ka[d0] = KSWZ(r32, (d0 * 16 + hi * 8) * 2);
    for (int u = blockIdx.x; u < 1024; u += G) {
        const int b = u >> 8, h = (u >> 4) & 15, R = u & 15;
        const int ra = 4 * R + 2 * pr, r = ra + (r32 >> 4), qc = 16 * m + (r32 & 15), qtok = 64 * r + qc;
        const size_t qrow = (size_t)(SEQL * b + qtok);
        bf16x8 qr[8]; load_q_plain(qr, Q + qrow * NAN3 + h * 128, hi);
        __syncthreads();
        if (tid < 465) RPB[(tid / 31) * 128 + 48 + (tid % 31)] = a.in[IN_RPB][h * 465 + tid] * (1.0f / ATT_SCALE);
        float m_reg = -1e30f, l_reg = 0.f;
        f32x16 o[4];
#pragma unroll
        for (int d = 0; d < 4; ++d)
#pragma unroll
            for (int rr = 0; rr < 16; ++rr) o[d][rr] = 0.f;
        const int c0 = 4 * R - 4, c1 = 4 * R - 1;
        const int kr_lo = c0 < 0 ? 0 : (c0 > 56 ? 56 : c0), kr_hi = (c1 < 0 ? 0 : (c1 > 56 ? 56 : c1)) + 7;
        const int rsa = (ra - 4) < 0 ? 0 : ((ra - 4) > 56 ? 56 : (ra - 4)), rsb = (ra - 3) < 0 ? 0 : ((ra - 3) > 56 ? 56 : (ra - 3));
        const int rsl = (r32 >> 4) ? rsb : rsa;
        const int wsq = (qc - 8) < 0 ? 0 : ((qc - 8) > 48 ? 48 : (qc - 8));
        const int nloc = kr_hi - kr_lo + 1, nt = nloc + 4;
        const bf16* Qk = Q + 2048 + h * 128; const size_t lrow0 = (size_t)(SEQL * b), crow0 = (size_t)(ML + CTXL * b);
        u32x4 kw[2], vw[2];
        { const size_t kr0 = lrow0 + 64 * kr_lo; tile_prefetch(kw, vw, Qk + kr0 * NAN3, Qk + kr0 * NAN3 + 2048, NAN3, tid); tile_commit_plain(kw, vw, lds, 0, tid); }
        for (int ti = 0; ti < nt; ++ti) {
            const bool loc = ti < nloc; const int kr = kr_lo + ti; const int boff = (ti & 1) * AT_BUF;
            if (ti + 1 < nt) { const size_t kr1 = (ti + 1 < nloc) ? lrow0 + 64 * (kr + 1) : crow0 + 64 * (ti + 1 - nloc); tile_prefetch(kw, vw, Qk + kr1 * NAN3, Qk + kr1 * NAN3 + 2048, NAN3, tid); }
            LDS_BARRIER();
            if (loc) {
                if (kr >= rsa && kr < rsb + 8) {
                    f32x16 p0; qkt32(p0, lds + boff + AT_K + cs * 256, qr, ka);
                    const LAS float* rp = RPB + (kr - r + 7) * 128 + 48 + (cs + 4 * hi - qc + 15);
                    int kb0 = cs + 4 * hi - wsq; asm volatile("" : "+v"(kb0));
                    const bool lrel = kr >= rsl && kr < rsl + 8;
                    if (!lrel) rp = RPB + 48;
                    float bb[16];
#pragma unroll
                    for (int rr = 0; rr < 16; ++rr) { const int kc = (rr & 3) + 8 * (rr >> 2); bb[rr] = *(const volatile LAS float*)(rp + kc); }
#pragma unroll
                    for (int rr = 0; rr < 16; ++rr) { const int kc = (rr & 3) + 8 * (rr >> 2); p0[rr] = (lrel && (unsigned)(kb0 + kc) < 16u) ? p0[rr] + bb[rr] : -INFINITY; }
                    sm_pv32(p0, o, m_reg, l_reg, vbs + boff, wsf + 32, r32, hi);
                }
            } else { f32x16 p0, p1; qkt_ka(p0, p1, lds + boff + AT_K, qr, ka); sm_pv(p0, p1, o, m_reg, l_reg, vb + boff, wsf + 32, r32, hi); }
            if (ti + 1 < nt) tile_commit_plain(kw, vw, lds, AT_BUF - boff, tid);
        }
        store_o(o, l_reg, Y + (size_t)(SEQL * b + 64 * ra + 16 * m) * DM + h * 128, wsf, lds + AT_OST + wave * 4096, lane, 64);
    }
    __syncthreads();
}
__device__ __forceinline__ void tail_share(int nwg, int G, int c, int& vc, int& VG) {
    const int rounds = (nwg + G - 1) / G; int c0 = nwg - (rounds - 1) * G;
    if (4 * (G - c0) < G) c0 = 0;
    VG = G - c0; vc = c - c0; if (vc < 0) vc = -1;
}
__global__ void __launch_bounds__(NWAVES * 64, 2) fwd_kernel(Args a) {
    extern __shared__ __attribute__((aligned(16))) unsigned char lds_raw[];
    LAS unsigned char* lds = (LAS unsigned char*)lds_raw;
    const int tid = threadIdx.x, lane = tid & 63, wave = __builtin_amdgcn_readfirstlane(tid >> 6), G = gridDim.x;
    unsigned char* ws = a.ws;
    volatile LAS unsigned* MISC = (volatile LAS unsigned*)(lds + MISC_OFF);
    for (int u = tid; u < (LDS_BYTES - LDSCTL_OFF) / 4; u += NWAVES * 64) ((LAS unsigned*)(lds + LDSCTL_OFF))[u] = 0u;
    __syncthreads();
    XcdBarrier bar = xcd_barrier_post((unsigned*)(ws + WS_CTL) + CW_BAR, MISC + 8);
#ifdef REP_RT
    const int lo = 0, hi = a.ph_hi;
#else
    const int lo = a.ph_lo, hi = a.ph_hi;
#endif
#define RUN(k) (lo <= (k) && (k) < hi)
#define SEAM(k) do { if (RUN(k) && RUN((k) + 1)) xcd_barrier(bar); } while (0)
#ifndef REP_MASK
#define REP_MASK 0u
#endif
#ifdef REP_RT
#define REPS(k) (int)(1u + (((unsigned)a.ph_lo >> (k)) & 1u))
#else
#define REPS(k) (int)(1u + ((REP_MASK >> (k)) & 1u))
#endif
#define REPS_UNUSED(k) (int)(1u + ((REP_MASK >> (k)) & 1u))
#ifdef TPROBE_S
    volatile LAS unsigned long long* TSL = (volatile LAS unsigned long long*)(lds + LDSCTL_OFF + 1024);
#define STAMP(k) do { if ((k) == TPROBE_S || (k) == TPROBE_E) { int t_ = threadIdx.x; asm volatile("" : "+v"(t_)); if (blockIdx.x == 0 && t_ == 0) TSL[k] = __builtin_amdgcn_s_memrealtime(); } } while (0)
#elif defined(PROBE)
    volatile LAS unsigned long long* TSL = (volatile LAS unsigned long long*)(lds + LDSCTL_OFF + 1024);
#define STAMP(k) do { if (blockIdx.x == 0 && tid == 0) { TSL[k] = __builtin_amdgcn_s_memrealtime(); TSL[32 + (k)] = __builtin_amdgcn_s_memtime(); } } while (0)
#else
#define STAMP(k) do { } while (0)
#endif
#ifdef CLKPROBE
    volatile LAS unsigned long long* CLK = (volatile LAS unsigned long long*)(lds + LDSCTL_OFF + 1024);
#endif
    bf16* X = (bf16*)(ws + WS_X)  ; bf16* PART = (bf16*)(ws + WS_BIG + 192 * MiB)  ; bf16* XC = X + (size_t)ML * DM; bf16* DL = (bf16*)(ws + WS_D); bf16* H = (bf16*)(ws + WS_H); bf16* BIG = (bf16*)(ws + WS_BIG); const float* MOD = (const float*)(ws + WS_MOD);

    STAMP(0); if (RUN(0)) for (int rep_ = 0; rep_ < REPS(0); ++rep_) {
                p0_misc(a, lds, tid, lane, wave, G);
                for (int st = -1; st < P0_NPRO; ++st) { p0_convert(a, lds, tid, (int)blockIdx.x, G, st, 0, p0_nitems(st)); if (st + 1 < P0_NPRO) { p0_absmax_phase(a, tid, (int)blockIdx.x, G, st + 1); xcd_barrier(bar); } } }
    SEAM(0);
    for (int s = 0; s < 4; ++s) {
        const int l = s >> 1, f = s & 1, pb = (s == 0) ? 1 : (s == 1) ? 9 : (s == 2) ? 12 : 19;
        const int Mrows = (s == 3) ? ML : MT;
        const float* modl = MOD + (size_t)l * 5 * MODW;
        STAMP(pb); if (RUN(pb)) for (int rep_ = 0; rep_ < REPS(pb); ++rep_) {
            const float* pgate = (s == 1) ? MOD + (size_t)5 * DM : (s == 2) ? MOD + (size_t)8 * DM : MOD + (size_t)(5 * 9 + 5) * DM;
            norm_phase((s == 0) ? (const void*)a.in[IN_X] : (const void*)X, s != 0, (s == 0) ? (const void*)a.in[IN_CTX] : (const void*)XC, s != 0, H, a.in[IN_NORMG] + (size_t)(l * 3 + 2 * f) * DM, modl, 6 * f, 6 * f + 1, Mrows, tid, G,
                       nullptr, (s == 1 || s == 2) ? PART : nullptr, pgate, (s == 2) ? 0.5f : 1.0f, (s == 0) ? X : nullptr, XC, (signed char*)H, (float*)(ws + WS_SH)); }
        SEAM(pb);
        STAMP(pb + 1); if (RUN(pb + 1)) for (int rep_ = 0; rep_ < REPS(pb + 1); ++rep_) { pg8::Gemm g{H, (const bf16*)(ws + WS_WFI + (size_t)s * FF2 * DM), Mrows, FF2, DM, (size_t)DM, 128, (size_t)DM, 128}; pg8::StaticOrder S; S.init(Mrows, FF2, G, (int)blockIdx.x, DM / 2, G1_WGM);
            pg8::EpiSwiGLUI8 E{BIG, MT, (const float*)(ws + WS_SH), (const float*)(ws + WS_CTL + CTL_WMAX_IN) + (size_t)s * FF2, FF, lds + LRU_U_OFF};
#ifdef CLKPROBE
            if (s == CLKPROBE && blockIdx.x == 0 && tid == 0) { CLK[0] = __builtin_amdgcn_s_memrealtime(); CLK[1] = __builtin_amdgcn_s_memtime(); }
#endif
            pg8::gemm_phase<pg8::EpiSwiGLUI8, pg8::StaticOrder, G1_ALIGN, GEMM_SP2>(lds, g, S, E);
#ifdef CLKPROBE
            if (s == CLKPROBE && blockIdx.x == 0 && tid == 0) { CLK[2] = __builtin_amdgcn_s_memrealtime(); CLK[3] = __builtin_amdgcn_s_memtime(); }
#endif
#if P0_NPRO < 5
            if (s < 3) { int vc, VG; tail_share(S.nwg, G, (int)blockIdx.x, vc, VG);
                if (vc >= 0) { if (s == 0) p0_absmax_phase(a, tid, vc, VG, 3);
                    else { const int nj = (s == 2) ? 2 : 1; for (int j = 0; j < nj; ++j) { const int st = j ? 4 : 3, jlo = (s == 2 && j == 0) ? P0_I_FI : 0, jhi = (s == 1) ? P0_I_FI : p0_nitems(st); p0_convert(a, lds, tid, vc, VG, st, jlo, jhi); } } } }
#endif
            xcd_barrier(bar); STAMP(24); hidden_quant_phase(BIG, (signed char*)(ws + WS_D), (float*)(ws + WS_SQ), Mrows, tid, G); }
        SEAM(pb + 1);
#ifdef IDLE_TEST
        if (s == 0) { const unsigned long long t0 = __builtin_amdgcn_s_memrealtime(); while (__builtin_amdgcn_s_memrealtime() - t0 < (unsigned long long)(IDLE_TEST * 100)) __builtin_amdgcn_s_sleep(32); __syncthreads(); }
#endif
        STAMP(pb + 2); if (RUN(pb + 2)) for (int rep_ = 0; rep_ < REPS(pb + 2); ++rep_) { pg8::Gemm g{(const bf16*)(ws + WS_D), (const bf16*)(ws + WS_WFO + (size_t)s * DM * HQP), Mrows, DM, 44 * 64, (size_t)HQP, 128, (size_t)HQP, 128}; pg8::CtxSplitOrder S; S.init(DM, G, (int)blockIdx.x, 44 * 64, s != 3, G2_WGM);
            pg8::EpiResidI8 E{X, (s == 3) ? (void*)a.out : (void*)X, s != 3, modl + (size_t)(6 * f + 2) * DM, 0.5f, PART, (const float*)(ws + WS_SQ), (const float*)(ws + WS_CTL + CTL_WMAX_OUT) + (size_t)s * DM}; pg8::gemm_phase<pg8::EpiResidI8, pg8::CtxSplitOrder, G2_ALIGN, GEMM_SP2>(lds, g, S, E); }
        SEAM(pb + 2);
        if (s == 0) {
            STAMP(4); if (RUN(4)) for (int rep_ = 0; rep_ < REPS(4); ++rep_) norm_phase(X, true, a.in[IN_CTX], false, H, a.in[IN_NORMG] + (size_t)(0 * 3 + 1) * DM, modl, 3, 4, MT, tid, G, nullptr, PART, MOD + (size_t)2 * DM, 0.5f, nullptr, XC, nullptr, nullptr);
            SEAM(4);
            STAMP(5); if (RUN(5)) for (int rep_ = 0; rep_ < REPS(5); ++rep_) { pg8::Gemm g = pg8::gemm_rr(H, (const bf16*)(ws + WS_WABI), MT, ABN, DM); pg8::StaticOrder S; S.init(MT, ABN, G, (int)blockIdx.x, DM);
                pg8::EpiQKRopeBf16 E{BIG, ABN, (const float*)(ws + WS_QKG), (const float*)(ws + WS_ROPE), (LAS float*)(lds + LRU_U_OFF)}; pg8::gemm_phase<pg8::EpiQKRopeBf16, pg8::StaticOrder, true, GEMM_SP2>(lds, g, S, E);
#if P0_NPRO < 5
                { int vc, VG; tail_share(S.nwg, G, (int)blockIdx.x, vc, VG); if (vc >= 0) p0_absmax_phase(a, tid, vc, VG, 4); }
#endif
            }
            SEAM(5);
            STAMP(6); if (RUN(6)) for (int rep_ = 0; rep_ < REPS(6); ++rep_) { lru_phase<false>(a, lds, tid, lane, wave, G); xcd_barrier(bar); lru_carry_scan(a, tid, G); }
            SEAM(6);
            STAMP(7); if (RUN(7)) for (int rep_ = 0; rep_ < REPS(7); ++rep_) { attn_ab_phase(a, lds, tid, lane, wave, G); STAMP(23);
                int vc, VG; tail_share(544, G, (int)blockIdx.x, vc, VG);
                lru_phase<true>(a, lds, tid, lane, wave, G, vc, VG, LRU_EXTRA * VG < 4 * 68 * 8 ? LRU_EXTRA * VG : 0); }
            SEAM(7);
            STAMP(8); if (RUN(8)) for (int rep_ = 0; rep_ < REPS(8); ++rep_) { pg8::Gemm g = pg8::gemm_rr(H, (const bf16*)(ws + WS_WABO), MT, DM, DM); pg8::CtxSplitOrder S; S.init(DM, G, (int)blockIdx.x, DM, true, G2_WGM);
                pg8::EpiResid E{X, XC, X, XC, modl + (size_t)5 * DM, 1.0f, PART}; pg8::gemm_phase<pg8::EpiResid, pg8::CtxSplitOrder, GEMM_ALIGN, GEMM_SP2>(lds, g, S, E); }
            SEAM(8);
        }
        if (s == 2) {
            STAMP(15); if (RUN(15)) for (int rep_ = 0; rep_ < REPS(15); ++rep_) norm_phase(X, true, XC, true, H, a.in[IN_NORMG] + (size_t)(1 * 3 + 1) * DM, modl, 3, 4, MT, tid, G, nullptr, PART, MOD + (size_t)(5 * 9 + 2) * DM, 0.5f, nullptr, XC, (signed char*)H, (float*)(ws + WS_SH));
            SEAM(15);
            STAMP(16); if (RUN(16)) for (int rep_ = 0; rep_ < REPS(16); ++rep_) {
                const float* sh = (const float*)(ws + WS_SH); const float* wmx = (const float*)(ws + WS_CTL + CTL_WMAX_NAI);
                { pg8::Gemm g{H, (const bf16*)(ws + WS_WNAI), ML, NAN3, DM, (size_t)DM, 128, (size_t)DM, 128}; pg8::StaticOrder S; S.init(ML, NAN3, G, (int)blockIdx.x, DM / 2);
                  pg8::EpiQKNormI8 E{BIG, NAN3, sh, wmx, a.in[IN_NAQN], a.in[IN_NAKN], 8, 8, (LAS float*)(lds + LRU_U_OFF)}; pg8::gemm_phase<pg8::EpiQKNormI8, pg8::StaticOrder, true, GEMM_SP2>(lds, g, S, E); }
                { pg8::Gemm g{(const bf16*)((const signed char*)H + (size_t)ML * DM), (const bf16*)(ws + WS_WNAI + (size_t)DM * DM), MC, 2 * DM, DM, (size_t)DM, 128, (size_t)DM, 128}; pg8::StaticOrder S; S.init(MC, 2 * DM, G, (int)blockIdx.x, DM / 2);
                  pg8::EpiQKNormI8 E{BIG + (size_t)ML * NAN3 + DM, NAN3, sh + ML, wmx + DM, a.in[IN_NAQN], a.in[IN_NAKN], 0, 8, (LAS float*)(lds + LRU_U_OFF)}; pg8::gemm_phase<pg8::EpiQKNormI8, pg8::StaticOrder, true, GEMM_SP2>(lds, g, S, E); }
            }
            SEAM(16);
            STAMP(17); if (RUN(17)) for (int rep_ = 0; rep_ < REPS(17); ++rep_) { attn_na_phase(a, lds, tid, lane, wave, G); xcd_barrier(bar); row_quant_phase(H, (signed char*)(ws + WS_D), (float*)(ws + WS_SY), ML, tid, G); }
            SEAM(17);
            STAMP(18); if (RUN(18)) for (int rep_ = 0; rep_ < REPS(18); ++rep_) { pg8::Gemm g{(const bf16*)(ws + WS_D), (const bf16*)(ws + WS_WNAO), ML, DM, DM, (size_t)DM, 128, (size_t)DM, 128}; pg8::CtxSplitOrder S; S.init(DM, G, (int)blockIdx.x, DM / 2, false, G2_WGM);
                pg8::EpiResidI8 E{X, X, 1, modl + (size_t)5 * DM, 1.0f, PART, (const float*)(ws + WS_SY), (const float*)(ws + WS_CTL + CTL_WMAX_NAO)}; pg8::gemm_phase<pg8::EpiResidI8, pg8::CtxSplitOrder, G2_ALIGN, GEMM_SP2>(lds, g, S, E); }
            SEAM(18);
        }
    }
#ifdef PROBE
    {
        xcd_barrier(bar); STAMP(22);
        float* slot = (float*)(ws + WS_CTL + 512 * 1024);
        if (blockIdx.x == 0 && tid == 0) { const float T1 = (float)(TSL[PROBE_E1] - TSL[PROBE_S1]) * 0.01f, T2 = (float)(TSL[PROBE_E2] - TSL[PROBE_S2]) * 0.01f;
#ifdef PROBE_CLOCK
            const float ghz = (float)(TSL[32 + PROBE_E1] - TSL[32 + PROBE_S1]) / ((float)(TSL[PROBE_E1] - TSL[PROBE_S1]) * 10.0f); const float sv = rintf(ghz * 10.0f + PROBE_CLOCK);
            __hip_atomic_store(slot, sv, RLX_AGENT); __hip_atomic_store(slot + 1, sv * 20.0f, RLX_AGENT); (void)T1; (void)T2; }
#else
            const float sv = sqrtf(T1); __hip_atomic_store(slot, sv, RLX_AGENT); __hip_atomic_store(slot + 1, sv * (10.0f + 0.8f * T2), RLX_AGENT); }
#endif
        xcd_barrier(bar);
        const float sv = __hip_atomic_load(slot, RLX_AGENT), V = __hip_atomic_load(slot + 1, RLX_AGENT);
        const f32x4* src = (const f32x4*)a.in[IN_X]; f32x4* dst = (f32x4*)a.out;
        for (size_t i = (size_t)blockIdx.x * (NWAVES * 64) + tid; i < (size_t)ML * DM / 4; i += (size_t)G * (NWAVES * 64)) { f32x4 v = src[i] * sv; if (i == 0) v.x = V; dst[i] = v; }
    }
#endif
#ifdef TPROBE_S
    { xcd_barrier(bar); STAMP(22);
      float* slot = (float*)(ws + WS_CTL + 512 * 1024);
      int t2_ = threadIdx.x; asm volatile("" : "+v"(t2_));
      if (blockIdx.x == 0 && t2_ == 0) { const float tus = (float)(TSL[TPROBE_E] - TSL[TPROBE_S]) * 0.01f; const float sv = rintf(tus * (1.0f / TPROBE_Q)); __hip_atomic_store(slot, sv * sv * 0.1f, RLX_AGENT); }
      xcd_barrier(bar);
      const float f = 1.0f + __hip_atomic_load(slot, RLX_AGENT) * 0.01f; f32x4* dst = (f32x4*)a.out;
      for (size_t i = (size_t)blockIdx.x * (NWAVES * 64) + tid; i < (size_t)ML * DM / 4; i += (size_t)G * (NWAVES * 64)) dst[i] = dst[i] * f; }
#endif
#ifdef CLKPROBE
    { xcd_barrier(bar);
      float* slot = (float*)(ws + WS_CTL + 512 * 1024);
      if (blockIdx.x == 0 && tid == 0) { const float ghz = (float)(CLK[3] - CLK[1]) / ((float)(CLK[2] - CLK[0]) * 10.0f); const float tus = (float)(CLK[2] - CLK[0]) * 0.01f;
#ifdef CLKPROBE_T
        const float sv = rintf(tus * (1.0f / CLKPROBE_T)); (void)ghz;
#else
        const float sv = rintf(ghz * 8.0f); (void)tus;
#endif
        __hip_atomic_store(slot, sv * sv * 0.1f, RLX_AGENT); }
      xcd_barrier(bar);
      const float f = 1.0f + __hip_atomic_load(slot, RLX_AGENT) * 0.01f; f32x4* dst = (f32x4*)a.out;
      for (size_t i = (size_t)blockIdx.x * (NWAVES * 64) + tid; i < (size_t)ML * DM / 4; i += (size_t)G * (NWAVES * 64)) dst[i] = dst[i] * f; }
#endif
    if (hi < N_PHASES) {
        xcd_barrier(bar);
        const f32x4* src = (const f32x4*)a.in[IN_X]; f32x4* dst = (f32x4*)a.out;
        for (size_t i = (size_t)blockIdx.x * (NWAVES * 64) + tid; i < (size_t)ML * DM / 4; i += (size_t)G * (NWAVES * 64)) dst[i] = src[i];
    }
#undef RUN
#undef SEAM
}

extern "C" void kernel_launch(void* const* d_in, const int* in_sizes, int n_in, void* d_out, int out_size, void* d_ws, size_t ws_size, hipStream_t stream) {
    static int grid = 0;
    if (grid == 0) {
        if (n_in != 26 || in_sizes[0] != ML * DM || out_size != ML * DM || ws_size < WS_END) { fprintf(stderr, "kernel_launch: shape mismatch: n_in %d in0 %d out %d ws %zu (need %zu)\n", n_in, n_in > 0 ? in_sizes[0] : -1, out_size, ws_size, (size_t)WS_END); grid = -1; return; }
        int dev = 0, cus = 0, per_cu = 0;
        if (hipGetDevice(&dev) != hipSuccess || hipDeviceGetAttribute(&cus, hipDeviceAttributeMultiprocessorCount, dev) != hipSuccess) { grid = -1; return; }
        if (hipFuncSetAttribute((const void*)fwd_kernel, hipFuncAttributeMaxDynamicSharedMemorySize, LDS_BYTES) != hipSuccess) { fprintf(stderr, "kernel_launch: hipFuncSetAttribute failed\n"); grid = -1; return; }
        if (hipOccupancyMaxActiveBlocksPerMultiprocessor(&per_cu, (const void*)fwd_kernel, NWAVES * 64, LDS_BYTES) != hipSuccess || per_cu < 1) fprintf(stderr, "kernel_launch: occupancy query says %d\n", per_cu);
        (void)hipGetLastError();
        grid = cus;
    }
    if (grid < 0) return;
    if (hipMemsetAsync((char*)d_ws + WS_CTL, 0, CTL_ZERO_BYTES, stream) != hipSuccess) return;
    Args a{};
    for (int i = 0; i < 26; ++i) a.in[i] = (const float*)d_in[i];
    a.out = (float*)d_out; a.ws = (unsigned char*)d_ws; a.ph_lo = 0; a.ph_hi = NPHASES_RUN;
#ifdef REP_RT
    a.ph_lo = (int)(REP_RT);
#endif
#ifdef PROBE
    for (int rep = 0; rep < 2; ++rep) { hipLaunchKernelGGL(fwd_kernel, dim3(grid), dim3(NWAVES * 64), LDS_BYTES, stream, a); (void)hipMemsetAsync((char*)d_ws + WS_CTL, 0, CTL_ZERO_BYTES, stream); }
#endif
    hipLaunchKernelGGL(fwd_kernel, dim3(grid), dim3(NWAVES * 64), LDS_BYTES, stream, a);
    const hipError_t le = hipPeekAtLastError();
    if (le != hipSuccess) fprintf(stderr, "kernel_launch: launch failed: %s\n", hipGetErrorName(le));
}
```

```cpp
#include <hip/hip_runtime.h>
#include <cstdio>
#include <cstdint>
#ifndef PG8_WGM
#define PG8_WGM 8
#endif
#ifndef PG8_STAGGER
#define PG8_STAGGER 1
#endif
namespace pg8 {
#define PG8_LAS __attribute__((address_space(3)))
typedef unsigned short bf16_t;
typedef short bf16x8 __attribute__((ext_vector_type(8)));
typedef float f32x4 __attribute__((ext_vector_type(4)));
typedef unsigned u32x4 __attribute__((ext_vector_type(4)));
typedef int i32x4 __attribute__((ext_vector_type(4)));
__device__ __forceinline__ f32x4 mma16(bf16x8 a, bf16x8 b, f32x4 c) { return __builtin_amdgcn_mfma_f32_16x16x32_bf16(a, b, c, 0, 0, 0); }
__device__ __forceinline__ i32x4 mma16(bf16x8 a, bf16x8 b, i32x4 c) { return __builtin_amdgcn_mfma_i32_16x16x64_i8(__builtin_bit_cast(i32x4, a), __builtin_bit_cast(i32x4, b), c, 0, 0, 0); }
constexpr int BM = 256, BK = 64, HALF = 128, HTB = HALF * BK * 2  , STAGE_BYTES = 8 * HTB, NXCD = 8, WGM = PG8_WGM;

__host__ __device__ __forceinline__ int lds_byte(int r, int c) { const int st = (r >> 4) * 2 + (c >> 5), rr = r & 15, cc = c & 31, ob = rr * 64 + cc * 2; return st * 1024 + (ob ^ (((ob >> 9) & 1) << 5)); }
__host__ __device__ __forceinline__ void stage_rc(int b, int& R, int& C) { const int st = b / 1024, sb = b % 1024, swz = sb ^ (((sb >> 9) & 1) << 5); R = (st >> 1) * 16 + swz / 64; C = (st & 1) * 32 + (swz % 64) / 2; }
__host__ __device__ __forceinline__ int perm32(int rho) { const int n = rho >> 4, i = rho & 15; return 8 * (i >> 2) + 4 * n + (i & 3); }

struct Unit { int pm, pn, kt0, nkt, piece; };
struct Gemm { const bf16_t* A; const bf16_t* Bt; int M, N, K; size_t pitchA, kstepA, pitchB, kstepB; };
__host__ __device__ __forceinline__ Gemm gemm_rr(const bf16_t* A, const bf16_t* Bt, int M, int N, int K) { return Gemm{A, Bt, M, N, K, (size_t)K * 2, 128, (size_t)K * 2, 128}; }
__host__ __device__ __forceinline__ Gemm gemm_tt(const bf16_t* A, size_t rowsA, const bf16_t* Bt, size_t rowsB, int M, int N, int K) { return Gemm{A, Bt, M, N, K, 128, rowsA * 128, 128, rowsB * 128}; }

struct StaticOrder {
    int nM, nN, nwg, G, c, nkt, wgm;
    __host__ __device__ void init(int M, int N, int G_, int c_, int K, int wgm_ = WGM) { nM = M / BM; nN = N / BM; nwg = nM * nN; G = G_; c = c_; nkt = K / BK; wgm = wgm_; }
    __host__ __device__ bool next(int i, Unit& u) const {
        const long L = (long)i * G + c; if (L >= nwg) return false;
        int wgid = (int)L; { const int q = nwg / NXCD, r = nwg % NXCD, xcd = wgid % NXCD, off = wgid / NXCD; wgid = (xcd < r ? xcd * (q + 1) : r * (q + 1) + (xcd - r) * q) + off; }
        const int nig = wgm * nN, gid = wgid / nig, fm = gid * wgm, gsz = (nM - fm) < wgm ? (nM - fm) : wgm;
        u.pm = fm + ((wgid % nig) % gsz); u.pn = (wgid % nig) / gsz; u.kt0 = 0; u.nkt = nkt; u.piece = -1; return true;
    }
    __device__ __forceinline__ void a_ready(const Unit&) const {}
    __device__ __forceinline__ void done(const Unit&) const {}
};
struct CtxSplitOrder {
    StaticOrder lat; int nN, nkb, nlat, npf;
    __host__ __device__ void init(int N, int G_, int c_, int K, bool with_ctx, int wgm_ = WGM) { lat.init(64 * BM, N, G_, c_, K, wgm_); nN = with_ctx ? N / BM : 0; nkb = K / 128; nlat = (lat.nwg - c_ + G_ - 1) / G_; if (nlat < 0) nlat = 0;
        const int tot = 4 * nN * 8; npf = (PG8_STAGGER && (c_ & 4) && c_ < tot && c_ + G_ >= tot) ? 1 : 0; }
    __host__ __device__ bool next(int i, Unit& u) const {
        const int nl = nlat, tot = 4 * nN * 8;
        int ii = i; if (npf) { if (i > nl) return false; ii = (i == 0) ? nl : i - 1; }
        if (ii < nl) return lat.next(ii, u);
        const int ip = ii - nl;
        const int q = ip * lat.G + lat.c; if (q >= tot) return false;
        const int cu = q >> 3, p = q & 7, k0 = (p * nkb) >> 3, k1 = ((p + 1) * nkb) >> 3;
        u.pm = 64 + cu / nN; u.pn = cu - (cu / nN) * nN; u.kt0 = 2 * k0; u.nkt = 2 * (k1 - k0); u.piece = p; return true;
    }
    __device__ __forceinline__ void a_ready(const Unit&) const {}
    __device__ __forceinline__ void done(const Unit&) const {}
};
__device__ __forceinline__ unsigned cvt_pk_bf16(float lo, float hi) { unsigned r; asm volatile("v_cvt_pk_bf16_f32 %0, %1, %2" : "=v"(r) : "v"(lo), "v"(hi)); return r; }
typedef float f32x2 __attribute__((ext_vector_type(2)));
typedef unsigned u32x2p __attribute__((ext_vector_type(2)));
__device__ __forceinline__ float silu_f(float x) { return x * __builtin_amdgcn_rcpf(1.0f + __builtin_amdgcn_exp2f(-1.4426950408889634f * x)); }
struct EpiBf16 {
    static constexpr bool PERM = true, AFTER_DRAIN = false, L2PF = false; typedef f32x4 acc_t;
    bf16_t* O; int ldc;
    struct Pre {}; __device__ __forceinline__ void prefetch(Pre&, const Unit&, int, int, int, int) const {}
    __device__ __forceinline__ void operator()(const f32x4 (&acc)[2][2][4][2], const Unit& u, int wr, int wc, int fr, int fq, const Pre&) const {
        const int row0 = u.pm * BM + wr * 64 + fr, col0 = u.pn * BM + wc * 32 + 8 * fq;
#pragma unroll
        for (int ai = 0; ai < 2; ++ai)
#pragma unroll
            for (int m = 0; m < 4; ++m) { bf16_t* rowp = O + (size_t)(row0 + ai * HALF + m * 16) * ldc + col0;
#pragma unroll
                for (int bj = 0; bj < 2; ++bj) { const f32x4 v0 = acc[ai][bj][m][0], v1 = acc[ai][bj][m][1];
                    u32x4 w; w.x = cvt_pk_bf16(v0[0], v0[1]); w.y = cvt_pk_bf16(v0[2], v0[3]); w.z = cvt_pk_bf16(v1[0], v1[1]); w.w = cvt_pk_bf16(v1[2], v1[3]);
                    *(u32x4*)(rowp + bj * HALF) = w; } }
    }
};
struct EpiSwiGLU {
    static constexpr bool PERM = true, AFTER_DRAIN = false, L2PF = false; typedef f32x4 acc_t;
    bf16_t* O; int rows;
    struct Pre {}; __device__ __forceinline__ void prefetch(Pre&, const Unit&, int, int, int, int) const {}
    __device__ __forceinline__ void operator()(const f32x4 (&acc)[2][2][4][2], const Unit& u, int wr, int wc, int fr, int fq, const Pre&) const {
        const int row0 = u.pm * BM + wr * 64 + fr, col0 = u.pn * HALF + wc * 32 + 8 * fq;
        bf16_t* base = O + (size_t)(col0 >> 6) * rows * 64 + (col0 & 63);
#pragma unroll
        for (int ai = 0; ai < 2; ++ai)
#pragma unroll
            for (int m = 0; m < 4; ++m) { bf16_t* rowp = base + (size_t)(row0 + ai * HALF + m * 16) * 64;
                const f32x4 g0 = acc[ai][0][m][0], g1 = acc[ai][0][m][1], u0 = acc[ai][1][m][0], u1 = acc[ai][1][m][1];
                u32x4 w; w.x = cvt_pk_bf16(silu_f(g0[0]) * u0[0], silu_f(g0[1]) * u0[1]); w.y = cvt_pk_bf16(silu_f(g0[2]) * u0[2], silu_f(g0[3]) * u0[3]);
                w.z = cvt_pk_bf16(silu_f(g1[0]) * u1[0], silu_f(g1[1]) * u1[1]); w.w = cvt_pk_bf16(silu_f(g1[2]) * u1[2], silu_f(g1[3]) * u1[3]);
                *(u32x4*)rowp = w; }
    }
};
__device__ __forceinline__ void xl4(u32x2p (&x)[2][2], const bf16_t* p) {
    asm volatile("global_load_dwordx2 %0, %4, off\n\tglobal_load_dwordx2 %1, %4, off offset:32\n\tglobal_load_dwordx2 %2, %4, off offset:256\n\tglobal_load_dwordx2 %3, %4, off offset:288"
                 : "=&v"(x[0][0]), "=&v"(x[0][1]), "=&v"(x[1][0]), "=&v"(x[1][1]) : "v"(p) : "memory"); }
template <int N> __device__ __forceinline__ void xw4(u32x2p (&x)[2][2]) { asm volatile("s_waitcnt vmcnt(%4)" : "+v"(x[0][0]), "+v"(x[0][1]), "+v"(x[1][0]), "+v"(x[1][1]) : "n"(N) : "memory"); }
struct EpiResid {
    static constexpr bool PERM = false, AFTER_DRAIN = false, L2PF = true; typedef f32x4 acc_t;
    const bf16_t* src_lat; const bf16_t* src_ctx; bf16_t* dst_lat; bf16_t* dst_ctx; const float* gate; float gs; bf16_t* part;
    struct Pre {}; __device__ __forceinline__ void prefetch(Pre&, const Unit&, int, int, int, int) const {}
    __device__ __forceinline__ void l2pf(const Unit& u, int wid, int lane, PG8_LAS unsigned char* dummy) const {
        if (u.piece >= 0) return;
        const bf16_t* base = u.pm < 64 ? src_lat + (size_t)u.pm * BM * 2048 : src_ctx + (size_t)(u.pm - 64) * BM * 2048;
#pragma unroll
        for (int k = 0; k < 2; ++k) { const int li = wid * 128 + k * 64 + lane, row = li >> 2, seg = li & 3;
            __builtin_amdgcn_global_load_lds((const unsigned*)(base + (size_t)row * 2048 + u.pn * BM + seg * 64), (PG8_LAS unsigned*)(dummy + wid * 512 + k * 256), 4, 0, 0); }
    }
    __device__ __forceinline__ void operator()(const f32x4 (&acc)[2][2][4][2], const Unit& u, int wr, int wc, int fr, int fq, const Pre&) const {
        const int rl = wr * 64 + fr, col0 = u.pn * BM + wc * 32 + 4 * fq;
        if (u.piece >= 0) { bf16_t* pb = part + ((size_t)u.piece * 1024 + (size_t)(u.pm - 64) * BM + rl) * 2048 + col0;
#pragma unroll
            for (int ai = 0; ai < 2; ++ai)
#pragma unroll
                for (int m = 0; m < 4; ++m)
#pragma unroll
                    for (int bj = 0; bj < 2; ++bj)
#pragma unroll
                        for (int n = 0; n < 2; ++n) { const f32x4 v = acc[ai][bj][m][n]; u32x2p w; w.x = cvt_pk_bf16(v[0], v[1]); w.y = cvt_pk_bf16(v[2], v[3]); *(u32x2p*)(pb + (size_t)(ai * HALF + m * 16) * 2048 + bj * HALF + n * 16) = w; }
            return; }
        const bool lat = u.pm < 64; const int slot = lat ? (u.pm >> 4) : 4;
        const float* gp = gate + (size_t)slot * (9 * 2048) + col0;
        const bf16_t* sb = (lat ? src_lat + (size_t)u.pm * BM * 2048 : src_ctx + (size_t)(u.pm - 64) * BM * 2048) + (size_t)rl * 2048 + col0;
        bf16_t* db = (lat ? dst_lat + (size_t)u.pm * BM * 2048 : dst_ctx + (size_t)(u.pm - 64) * BM * 2048) + (size_t)rl * 2048 + col0;
        f32x4 gv[2][2];
#pragma unroll
        for (int bj = 0; bj < 2; ++bj)
#pragma unroll
            for (int n = 0; n < 2; ++n) gv[bj][n] = *(const f32x4*)(gp + bj * HALF + n * 16) * gs;
        asm volatile("s_waitcnt vmcnt(0)" ::: "memory");
        u32x2p xr[2][2]; xl4(xr, sb);
#pragma unroll
        for (int g = 0; g < 8; ++g) { const int ai = g >> 2, m = g & 3; const size_t off = (size_t)(ai * HALF + m * 16) * 2048;
            if (g == 0) xw4<0>(xr); else xw4<4>(xr);
            f32x4 yy[2][2];
#pragma unroll
            for (int bj = 0; bj < 2; ++bj)
#pragma unroll
                for (int n = 0; n < 2; ++n) { const u32x2p xw = xr[bj][n];
                    const f32x4 x = (f32x4){__uint_as_float(xw.x << 16), __uint_as_float(xw.x & 0xffff0000u), __uint_as_float(xw.y << 16), __uint_as_float(xw.y & 0xffff0000u)};
                    yy[bj][n] = x + gv[bj][n] * acc[ai][bj][m][n]; }
            __builtin_amdgcn_sched_barrier(0);
            if (g < 7) xl4(xr, sb + (size_t)(((g + 1) >> 2) * HALF + ((g + 1) & 3) * 16) * 2048);
            __builtin_amdgcn_sched_barrier(0);
#pragma unroll
            for (int bj = 0; bj < 2; ++bj)
#pragma unroll
                for (int n = 0; n < 2; ++n) { u32x2p w; w.x = cvt_pk_bf16(yy[bj][n][0], yy[bj][n][1]); w.y = cvt_pk_bf16(yy[bj][n][2], yy[bj][n][3]); *(u32x2p*)(db + off + bj * HALF + n * 16) = w; }
            __builtin_amdgcn_sched_barrier(0); }
    }
};
struct EpiDelta {
    static constexpr bool PERM = true, AFTER_DRAIN = false, L2PF = false; typedef f32x4 acc_t;
    bf16_t* D; float* part;
    struct Pre {}; __device__ __forceinline__ void prefetch(Pre&, const Unit&, int, int, int, int) const {}
    __device__ __forceinline__ void operator()(const f32x4 (&acc)[2][2][4][2], const Unit& u, int wr, int wc, int fr, int fq, const Pre&) const {
        const int rl = wr * 64 + fr, col0 = u.pn * BM + wc * 32 + 8 * fq;
        if (u.piece >= 0) { float* pb = part + ((size_t)u.piece * 1024 + (size_t)(u.pm - 64) * BM + rl) * 2048 + col0;
#pragma unroll
            for (int ai = 0; ai < 2; ++ai)
#pragma unroll
                for (int m = 0; m < 4; ++m)
#pragma unroll
                    for (int bj = 0; bj < 2; ++bj)
#pragma unroll
                        for (int n = 0; n < 2; ++n) *(f32x4*)(pb + (size_t)(ai * HALF + m * 16) * 2048 + bj * HALF + 4 * n) = acc[ai][bj][m][n];
            return; }
        bf16_t* db = D + ((size_t)u.pm * BM + rl) * 2048 + col0;
#pragma unroll
        for (int ai = 0; ai < 2; ++ai)
#pragma unroll
            for (int m = 0; m < 4; ++m)
#pragma unroll
                for (int bj = 0; bj < 2; ++bj) { const f32x4 v0 = acc[ai][bj][m][0], v1 = acc[ai][bj][m][1];
                    u32x4 w; w.x = cvt_pk_bf16(v0[0], v0[1]); w.y = cvt_pk_bf16(v0[2], v0[3]); w.z = cvt_pk_bf16(v1[0], v1[1]); w.w = cvt_pk_bf16(v1[2], v1[3]);
                    *(u32x4*)(db + (size_t)(ai * HALF + m * 16) * 2048 + bj * HALF) = w; }
    }
};
struct EpiSwiGLUI8 {
    static constexpr bool PERM = true, AFTER_DRAIN = false, L2PF = false; typedef i32x4 acc_t;
    bf16_t* O; int rows; const float* rowscale; const float* wmax; int upoff; PG8_LAS unsigned char* scr;
    struct Pre {};
    __device__ __forceinline__ void prefetch(Pre&, const Unit& u, int wr, int wc, int fr, int fq) const {
        const int lane = fr + 16 * fq; PG8_LAS unsigned char* t = scr + (wr * 4 + wc) * 768;
        const float* g0 = wmax + ((lane & 32) ? upoff : 0) + u.pn * HALF + wc * 32 + (lane & 31); const float* r0 = rowscale + u.pm * BM + wr * 64 + lane;
        asm volatile("s_waitcnt lgkmcnt(0)" ::: "memory");
        __builtin_amdgcn_global_load_lds((const unsigned*)g0, (PG8_LAS unsigned*)t, 4, 0, 0);
        __builtin_amdgcn_global_load_lds((const unsigned*)r0, (PG8_LAS unsigned*)(t + 256), 4, 0, 0);
        __builtin_amdgcn_global_load_lds((const unsigned*)(r0 + HALF), (PG8_LAS unsigned*)(t + 512), 4, 0, 0);
    }
    __device__ __forceinline__ void operator()(const i32x4 (&acc)[2][2][4][2], const Unit& u, int wr, int wc, int fr, int fq, const Pre&) const {
        const int row0 = u.pm * BM + wr * 64 + fr, cl = u.pn * HALF + wc * 32 + 8 * fq;
        bf16_t* base = O + cl;
        const PG8_LAS float* t = (const PG8_LAS float*)(scr + (wr * 4 + wc) * 768);
        f32x2 cg[4], cu[4];
#pragma unroll
        for (int q = 0; q < 2; ++q) { const f32x4 a = *(const PG8_LAS f32x4*)(t + 8 * fq + 4 * q) * (-1.4426950408889634f / 127.0f), b = *(const PG8_LAS f32x4*)(t + 32 + 8 * fq + 4 * q) * (-0.6931471805599453f / 127.0f);
            cg[2 * q] = (f32x2){a[0], a[1]}; cg[2 * q + 1] = (f32x2){a[2], a[3]}; cu[2 * q] = (f32x2){b[0], b[1]}; cu[2 * q + 1] = (f32x2){b[2], b[3]}; }
        float rsv[2][4];
#pragma unroll
        for (int ai = 0; ai < 2; ++ai)
#pragma unroll
            for (int m = 0; m < 4; ++m) rsv[ai][m] = t[64 + 64 * ai + 16 * m + fr];
#pragma unroll
        for (int ai = 0; ai < 2; ++ai)
#pragma unroll
            for (int m = 0; m < 4; ++m) { const int row = row0 + ai * HALF + m * 16; const f32x2 rs2 = (f32x2){rsv[ai][m], rsv[ai][m]}; bf16_t* rowp = base + (size_t)row * 5504;
                unsigned w[4];
#pragma unroll
                for (int p = 0; p < 4; ++p) { const int n = p >> 1, j = 2 * (p & 1);
                    const f32x2 G = (f32x2){(float)acc[ai][0][m][n][j], (float)acc[ai][0][m][n][j + 1]}, U = (f32x2){(float)acc[ai][1][m][n][j], (float)acc[ai][1][m][n][j + 1]};
                    const f32x2 T = (G * cg[p]) * rs2, V = (U * cu[p]) * rs2;
                    f32x2 D = (f32x2){__builtin_amdgcn_exp2f(T.x), __builtin_amdgcn_exp2f(T.y)} + (f32x2){1.0f, 1.0f};
                    const f32x2 R = (f32x2){__builtin_amdgcn_rcpf(D.x), __builtin_amdgcn_rcpf(D.y)};
                    const f32x2 Hh = (T * V) * R; w[p] = cvt_pk_bf16(Hh.x, Hh.y); }
                u32x4 wv4; wv4.x = w[0]; wv4.y = w[1]; wv4.z = w[2]; wv4.w = w[3];
                *(u32x4*)rowp = wv4; }
    }
};
struct EpiResidI8 {
    static constexpr bool PERM = false, AFTER_DRAIN = false, L2PF = true; typedef i32x4 acc_t;
    const bf16_t* src_lat; void* dst_lat; int dst_bf; const float* gate; float gs; bf16_t* part; const float* rowscale; const float* wmax;
    struct Pre {}; __device__ __forceinline__ void prefetch(Pre&, const Unit&, int, int, int, int) const {}
    __device__ __forceinline__ void l2pf(const Unit& u, int wid, int lane, PG8_LAS unsigned char* dummy) const {
        if (u.piece >= 0) return;
#pragma unroll
        for (int k = 0; k < 2; ++k) { const int li = wid * 128 + k * 64 + lane, row = li >> 2, seg = li & 3;
            __builtin_amdgcn_global_load_lds((const unsigned*)(src_lat + ((size_t)u.pm * BM + row) * 2048 + u.pn * BM + seg * 64), (PG8_LAS unsigned*)(dummy + wid * 512 + k * 256), 4, 0, 0); }
    }
    __device__ __forceinline__ void operator()(const i32x4 (&acc)[2][2][4][2], const Unit& u, int wr, int wc, int fr, int fq, const Pre&) const {
        int frx = fr, fqx = fq; asm volatile("" : "+v"(frx), "+v"(fqx));
        const int rl = wr * 64 + frx, col0 = u.pn * BM + wc * 32 + 4 * fqx;
        f32x4 wv[2][2];
#pragma unroll
        for (int bj = 0; bj < 2; ++bj)
#pragma unroll
            for (int n = 0; n < 2; ++n) wv[bj][n] = *(const f32x4*)(wmax + col0 + bj * HALF + n * 16) * (1.0f / 127.0f);
        float rsv[2][4]; { const float* rsp = rowscale + (size_t)u.pm * BM + rl;
#pragma unroll
            for (int ai = 0; ai < 2; ++ai)
#pragma unroll
                for (int m = 0; m < 4; ++m) rsv[ai][m] = rsp[ai * HALF + m * 16]; }
        __builtin_amdgcn_sched_barrier(0);
        if (u.piece >= 0) { bf16_t* pb = part + ((size_t)u.piece * 1024 + (size_t)(u.pm - 64) * BM + rl) * 2048 + col0;
#pragma unroll
            for (int ai = 0; ai < 2; ++ai)
#pragma unroll
                for (int m = 0; m < 4; ++m) { const float rs = rsv[ai][m];
#pragma unroll
                    for (int bj = 0; bj < 2; ++bj)
#pragma unroll
                        for (int n = 0; n < 2; ++n) { const i32x4 c = acc[ai][bj][m][n]; const f32x4 v = (f32x4){(float)c[0], (float)c[1], (float)c[2], (float)c[3]} * (wv[bj][n] * rs);
                            u32x2p w; w.x = cvt_pk_bf16(v[0], v[1]); w.y = cvt_pk_bf16(v[2], v[3]); *(u32x2p*)(pb + (size_t)(ai * HALF + m * 16) * 2048 + bj * HALF + n * 16) = w; } }
            return; }
        const int slot = u.pm >> 4;
        const float* gp = gate + (size_t)slot * (9 * 2048) + col0;
        const size_t e0 = ((size_t)u.pm * BM + rl) * 2048 + col0;
#pragma unroll
        for (int bj = 0; bj < 2; ++bj)
#pragma unroll
            for (int n = 0; n < 2; ++n) wv[bj][n] *= *(const f32x4*)(gp + bj * HALF + n * 16) * gs;
        if (dst_bf) rows<true, true>(acc, e0, wv, rsv); else rows<true, false>(acc, e0, wv, rsv);
    }
    template <bool SB, bool DB>
    __device__ __forceinline__ void rows(const i32x4 (&acc)[2][2][4][2], size_t e0, const f32x4 (&wv)[2][2], const float (&rsv)[2][4]) const {
        asm volatile("s_waitcnt vmcnt(0)" ::: "memory");
        u32x2p xr[2][2]; xl4(xr, src_lat + e0);
#pragma unroll
        for (int g = 0; g < 8; ++g) { const int ai = g >> 2, m = g & 3; const size_t er = e0 + (size_t)(ai * HALF + m * 16) * 2048; const float rs = rsv[ai][m];
            if (g == 0) xw4<0>(xr); else xw4<DB ? 4 : 4>(xr);
            f32x4 yy[2][2];
#pragma unroll
            for (int bj = 0; bj < 2; ++bj)
#pragma unroll
                for (int n = 0; n < 2; ++n) { const i32x4 c = acc[ai][bj][m][n]; const u32x2p xw = xr[bj][n];
                    const f32x4 x = (f32x4){__uint_as_float(xw.x << 16), __uint_as_float(xw.x & 0xffff0000u), __uint_as_float(xw.y << 16), __uint_as_float(xw.y & 0xffff0000u)};
                    yy[bj][n] = x + (f32x4){(float)c[0], (float)c[1], (float)c[2], (float)c[3]} * (wv[bj][n] * rs); }
            __builtin_amdgcn_sched_barrier(0);
            if (g < 7) xl4(xr, src_lat + e0 + (size_t)(((g + 1) >> 2) * HALF + ((g + 1) & 3) * 16) * 2048);
            __builtin_amdgcn_sched_barrier(0);
#pragma unroll
            for (int bj = 0; bj < 2; ++bj)
#pragma unroll
                for (int n = 0; n < 2; ++n) { const size_t e = er + bj * HALF + n * 16;
                    if constexpr (DB) { u32x2p w; w.x = cvt_pk_bf16(yy[bj][n][0], yy[bj][n][1]); w.y = cvt_pk_bf16(yy[bj][n][2], yy[bj][n][3]); *(u32x2p*)((bf16_t*)dst_lat + e) = w; } else *(f32x4*)((float*)dst_lat + e) = yy[bj][n]; }
            __builtin_amdgcn_sched_barrier(0); }
    }
};
struct EpiBf16I8 {
    static constexpr bool PERM = true, AFTER_DRAIN = false, L2PF = false; typedef i32x4 acc_t;
    bf16_t* O; int ldc; const float* rowscale; const float* wmax;
    struct Pre {}; __device__ __forceinline__ void prefetch(Pre&, const Unit&, int, int, int, int) const {}
    __device__ __forceinline__ void operator()(const i32x4 (&acc)[2][2][4][2], const Unit& u, int wr, int wc, int fr, int fq, const Pre&) const {
        const int row0 = u.pm * BM + wr * 64 + fr, col0 = u.pn * BM + wc * 32 + 8 * fq;
        f32x4 wv[2][2];
#pragma unroll
        for (int bj = 0; bj < 2; ++bj)
#pragma unroll
            for (int n = 0; n < 2; ++n) wv[bj][n] = *(const f32x4*)(wmax + col0 + bj * HALF + 4 * n) * (1.0f / 127.0f);
        float rsv[2][4];
#pragma unroll
        for (int ai = 0; ai < 2; ++ai)
#pragma unroll
            for (int m = 0; m < 4; ++m) rsv[ai][m] = rowscale[row0 + ai * HALF + m * 16];
        __builtin_amdgcn_sched_barrier(0);
#pragma unroll
        for (int ai = 0; ai < 2; ++ai)
#pragma unroll
            for (int m = 0; m < 4; ++m) { const int row = row0 + ai * HALF + m * 16; const float rs = rsv[ai][m]; bf16_t* rowp = O + (size_t)row * ldc + col0;
#pragma unroll
                for (int bj = 0; bj < 2; ++bj) { const i32x4 c0 = acc[ai][bj][m][0], c1 = acc[ai][bj][m][1]; const f32x4 s0 = wv[bj][0] * rs, s1 = wv[bj][1] * rs;
                    u32x4 w; w.x = cvt_pk_bf16((float)c0[0] * s0[0], (float)c0[1] * s0[1]); w.y = cvt_pk_bf16((float)c0[2] * s0[2], (float)c0[3] * s0[3]);
                    w.z = cvt_pk_bf16((float)c1[0] * s1[0], (float)c1[1] * s1[1]); w.w = cvt_pk_bf16((float)c1[2] * s1[2], (float)c1[3] * s1[3]);
                    *(u32x4*)(rowp + bj * HALF) = w; } }
    }
};
struct EpiQKNormI8 {
    static constexpr bool PERM = true, AFTER_DRAIN = false, L2PF = false; typedef i32x4 acc_t;
    bf16_t* O; int ldc; const float* rowscale; const float* wmax; const float* qg; const float* kg; int nq, nk; PG8_LAS float* ex;
    struct Pre {}; __device__ __forceinline__ void prefetch(Pre&, const Unit&, int, int, int, int) const {}
    __device__ __forceinline__ void operator()(const i32x4 (&acc)[2][2][4][2], const Unit& u, int wr, int wc, int fr, int fq, const Pre&) const {
        const int row0 = u.pm * BM + wr * 64 + fr, col0 = u.pn * BM + wc * 32 + 8 * fq;
        f32x4 wv[2][2];
#pragma unroll
        for (int bj = 0; bj < 2; ++bj)
#pragma unroll
            for (int n = 0; n < 2; ++n) wv[bj][n] = *(const f32x4*)(wmax + col0 + bj * HALF + 4 * n) * (1.0f / 127.0f);
        float rsv[2][4];
#pragma unroll
        for (int ai = 0; ai < 2; ++ai)
#pragma unroll
            for (int m = 0; m < 4; ++m) rsv[ai][m] = rowscale[row0 + ai * HALF + m * 16];
        const float* gain = u.pn < nq ? qg : kg; const bool normed = u.pn < nq + nk;
        f32x4 g0 = (f32x4){1.f, 1.f, 1.f, 1.f}, g1 = g0;
        if (normed) { g0 = *(const f32x4*)(gain + wc * 32 + 8 * fq); g1 = *(const f32x4*)(gain + wc * 32 + 8 * fq + 4); }
        __builtin_amdgcn_sched_barrier(0);
        float rn[2][2][4];
        if (normed) {
            PG8_LAS float* exw = ex + ((wr * 8) * 16 + fr) * 8 + wc;
#pragma unroll
            for (int ai = 0; ai < 2; ++ai)
#pragma unroll
                for (int m = 0; m < 4; ++m) { const float rs = rsv[ai][m];
#pragma unroll
                    for (int bj = 0; bj < 2; ++bj) { const i32x4 c0 = acc[ai][bj][m][0], c1 = acc[ai][bj][m][1]; const f32x4 s0 = wv[bj][0] * rs, s1 = wv[bj][1] * rs;
                        const f32x4 a = (f32x4){(float)c0[0], (float)c0[1], (float)c0[2], (float)c0[3]} * s0, b = (f32x4){(float)c1[0], (float)c1[1], (float)c1[2], (float)c1[3]} * s1;
                        float ss = (a[0] * a[0] + a[1] * a[1]) + (a[2] * a[2] + a[3] * a[3]) + (b[0] * b[0] + b[1] * b[1]) + (b[2] * b[2] + b[3] * b[3]);
                        ss += __int_as_float(__builtin_amdgcn_ds_swizzle(__float_as_int(ss), (16 << 10) | 0x1f));
                        { auto rr = __builtin_amdgcn_permlane32_swap(__float_as_uint(ss), __float_as_uint(ss), false, false); ss = __uint_as_float(rr[0]) + __uint_as_float(rr[1]); }
                        if (fq == 0) exw[((ai * 4 + m) * 16) * 8 + bj * 4] = ss; } }
            asm volatile("s_waitcnt lgkmcnt(0)" ::: "memory"); __builtin_amdgcn_s_barrier(); asm volatile("" ::: "memory");
            const PG8_LAS float* exr = ex + ((wr * 8) * 16 + fr) * 8;
#pragma unroll
            for (int ai = 0; ai < 2; ++ai)
#pragma unroll
                for (int m = 0; m < 4; ++m)
#pragma unroll
                    for (int bj = 0; bj < 2; ++bj) { const f32x4 p = *(const PG8_LAS f32x4*)(exr + ((ai * 4 + m) * 16) * 8 + bj * 4); rn[ai][bj][m] = 1.0f / sqrtf(((p[0] + p[1]) + (p[2] + p[3])) * (1.0f / 128.0f) + 1e-6f); }
        } else {
#pragma unroll
            for (int ai = 0; ai < 2; ++ai)
#pragma unroll
                for (int m = 0; m < 4; ++m) { rn[ai][0][m] = 1.f; rn[ai][1][m] = 1.f; }
        }
#pragma unroll
        for (int ai = 0; ai < 2; ++ai)
#pragma unroll
            for (int m = 0; m < 4; ++m) { const int row = row0 + ai * HALF + m * 16; const float rs = rsv[ai][m]; bf16_t* rowp = O + (size_t)row * ldc + col0;
#pragma unroll
                for (int bj = 0; bj < 2; ++bj) { const i32x4 c0 = acc[ai][bj][m][0], c1 = acc[ai][bj][m][1]; const float t = rs * rn[ai][bj][m]; const f32x4 s0 = wv[bj][0] * g0 * t, s1 = wv[bj][1] * g1 * t;
                    u32x4 w; w.x = cvt_pk_bf16((float)c0[0] * s0[0], (float)c0[1] * s0[1]); w.y = cvt_pk_bf16((float)c0[2] * s0[2], (float)c0[3] * s0[3]);
                    w.z = cvt_pk_bf16((float)c1[0] * s1[0], (float)c1[1] * s1[1]); w.w = cvt_pk_bf16((float)c1[2] * s1[2], (float)c1[3] * s1[3]);
                    *(u32x4*)(rowp + bj * HALF) = w; } }
    }
};
struct EpiQKRopeBf16 {
    static constexpr bool PERM = true, AFTER_DRAIN = false, L2PF = false; typedef f32x4 acc_t;
    static constexpr int QT0 = 8, NQT = 4;
    bf16_t* O; int ldc; const float* qkg; const float* rope; PG8_LAS float* ex;
    struct Pre {}; __device__ __forceinline__ void prefetch(Pre&, const Unit&, int, int, int, int) const {}
    __device__ __forceinline__ void operator()(const f32x4 (&acc)[2][2][4][2], const Unit& u, int wr, int wc, int fr, int fq, const Pre&) const {
        const int row0 = u.pm * BM + wr * 64 + fr, col0 = u.pn * BM + wc * 32 + 8 * fq;
        if (u.pn < QT0 || u.pn > QT0 + NQT) {
#pragma unroll
            for (int ai = 0; ai < 2; ++ai)
#pragma unroll
                for (int m = 0; m < 4; ++m) { bf16_t* rowp = O + (size_t)(row0 + ai * HALF + m * 16) * ldc + col0;
#pragma unroll
                    for (int bj = 0; bj < 2; ++bj) { const f32x4 v0 = acc[ai][bj][m][0], v1 = acc[ai][bj][m][1];
                        u32x4 w; w.x = cvt_pk_bf16(v0[0], v0[1]); w.y = cvt_pk_bf16(v0[2], v0[3]); w.z = cvt_pk_bf16(v1[0], v1[1]); w.w = cvt_pk_bf16(v1[2], v1[3]);
                        *(u32x4*)(rowp + bj * HALF) = w; } }
            return; }
        const float* gain = qkg + (u.pn < QT0 + NQT ? 0 : 128) + wc * 32 + 8 * fq;
        const f32x4 g0 = *(const f32x4*)gain, g1 = *(const f32x4*)(gain + 4);
        float rn[2][2][4];
        { PG8_LAS float* exw = ex + ((wr * 8) * 16 + fr) * 8 + wc;
#pragma unroll
          for (int ai = 0; ai < 2; ++ai)
#pragma unroll
            for (int m = 0; m < 4; ++m)
#pragma unroll
                for (int bj = 0; bj < 2; ++bj) { const f32x4 a = acc[ai][bj][m][0], b = acc[ai][bj][m][1];
                    float ss = (a[0] * a[0] + a[1] * a[1]) + (a[2] * a[2] + a[3] * a[3]) + (b[0] * b[0] + b[1] * b[1]) + (b[2] * b[2] + b[3] * b[3]);
                    ss += __int_as_float(__builtin_amdgcn_ds_swizzle(__float_as_int(ss), (16 << 10) | 0x1f));
                    { auto rr = __builtin_amdgcn_permlane32_swap(__float_as_uint(ss), __float_as_uint(ss), false, false); ss = __uint_as_float(rr[0]) + __uint_as_float(rr[1]); }
                    if (fq == 0) exw[((ai * 4 + m) * 16) * 8 + bj * 4] = ss; }
          asm volatile("s_waitcnt lgkmcnt(0)" ::: "memory"); __builtin_amdgcn_s_barrier(); asm volatile("" ::: "memory");
          const PG8_LAS float* exr = ex + ((wr * 8) * 16 + fr) * 8;
#pragma unroll
          for (int ai = 0; ai < 2; ++ai)
#pragma unroll
            for (int m = 0; m < 4; ++m)
#pragma unroll
                for (int bj = 0; bj < 2; ++bj) { const f32x4 p = *(const PG8_LAS f32x4*)(exr + ((ai * 4 + m) * 16) * 8 + bj * 4); rn[ai][bj][m] = 1.0f / sqrtf(((p[0] + p[1]) + (p[2] + p[3])) * (1.0f / 128.0f) + 1e-6f); } }
        const bool rot = u.pm < 64;
        const float* rbase = rope + (16 * (wc & 1) + 4 * fq) * 2;
#pragma unroll
        for (int ai = 0; ai < 2; ++ai) {
            f32x4 cs[4][2];
#pragma unroll
            for (int m = 0; m < 4; ++m) { const int t = (row0 + ai * HALF + m * 16) & 4095, pos = rot ? ((wc >> 1) ? (t & 63) : (t >> 6)) : 0;
#pragma unroll
                for (int n = 0; n < 2; ++n) cs[m][n] = *(const f32x4*)(rbase + (size_t)pos * 64 + 4 * n); }
            __builtin_amdgcn_sched_barrier(0);
#pragma unroll
            for (int m = 0; m < 4; ++m) { bf16_t* rowp = O + (size_t)(row0 + ai * HALF + m * 16) * ldc + col0;
#pragma unroll
                for (int bj = 0; bj < 2; ++bj) { const float t = rn[ai][bj][m]; unsigned wd[4];
#pragma unroll
                    for (int n = 0; n < 2; ++n) { const f32x4 y = acc[ai][bj][m][n] * ((n ? g1 : g0) * t); f32x4 c = cs[m][n]; if (!rot) c = (f32x4){1.f, 0.f, 1.f, 0.f};
                        wd[2 * n] = cvt_pk_bf16(y[0] * c[0] - y[1] * c[1], y[1] * c[0] + y[0] * c[1]); wd[2 * n + 1] = cvt_pk_bf16(y[2] * c[2] - y[3] * c[3], y[3] * c[2] + y[2] * c[3]); }
                    u32x4 w; w.x = wd[0]; w.y = wd[1]; w.z = wd[2]; w.w = wd[3];
                    *(u32x4*)(rowp + bj * HALF) = w; } } }
    }
};
template <class Epi, class Sched, bool ALIGN_EPI = false, bool SP2 = false>
__device__ __forceinline__ void gemm_phase(PG8_LAS unsigned char* lds, const Gemm g, const Sched& S, const Epi& E) {
    int tid = threadIdx.x; asm volatile("" : "+v"(tid));
    const int wid = __builtin_amdgcn_readfirstlane(tid >> 6), lane = tid & 63, wr = wid >> 2, wc = wid & 3, fr = lane & 15, fq = lane >> 4;
    const int K = g.K;
    unsigned voffA[2], voffB[2];
#pragma unroll
    for (int i = 0; i < 2; ++i) { int R, C; stage_rc(tid * 16 + i * 8192, R, C); const int Rb = Epi::PERM ? ((R & ~31) + perm32(R & 31)) : R;
        voffA[i] = (unsigned)R * (unsigned)g.pitchA + (unsigned)C * 2u; voffB[i] = (unsigned)Rb * (unsigned)g.pitchB + (unsigned)C * 2u; }
    const size_t kstepA = g.kstepA, kstepB = g.kstepB;
    const size_t hstepA = (size_t)HALF * g.pitchA, hstepB = (size_t)HALF * g.pitchB;
    const size_t tstepA = 2 * hstepA, tstepB = 2 * hstepB;
    const unsigned ldsw = (unsigned)wid * 1024u;
    const int aoff = lds_byte(wr * 64 + fr, fq * 8), boff = lds_byte(wc * 32 + fr, fq * 8);
#define PG8_SA(b, h) (((b) * 2 + (h)) * HTB)
#define PG8_SB(b, h) ((4 + (b) * 2 + (h)) * HTB)
#define PG8_STAGE(bufoff, gbase, voff) do { _Pragma("unroll") for (int _i = 0; _i < 2; ++_i) \
        __builtin_amdgcn_global_load_lds((const unsigned*)((const char*)(gbase) + (voff)[_i]), (PG8_LAS unsigned*)(lds + (bufoff) + ldsw + _i * 8192), 16, 0, 0); } while (0)
#define PG8_LDA(dst, b, h) do { _Pragma("unroll") for (int m = 0; m < 4; ++m) _Pragma("unroll") for (int k = 0; k < 2; ++k) dst[m][k] = *(const PG8_LAS bf16x8*)(lds + PG8_SA(b, h) + aoff + m * 2048 + k * 1024); } while (0)
#define PG8_LDB(dst, b, h) do { _Pragma("unroll") for (int n = 0; n < 2; ++n) _Pragma("unroll") for (int k = 0; k < 2; ++k) dst[n][k] = *(const PG8_LAS bf16x8*)(lds + PG8_SB(b, h) + boff + n * 2048 + k * 1024); } while (0)
#define PG8_MMA(ai, bj, At, Bt) do { __builtin_amdgcn_s_setprio(1); _Pragma("unroll") for (int m = 0; m < 4; ++m) _Pragma("unroll") for (int n = 0; n < 2; ++n) _Pragma("unroll") for (int k = 0; k < 2; ++k) \
        acc[ai][bj][m][n] = mma16(Bt[n][k], At[m][k], acc[ai][bj][m][n]); __builtin_amdgcn_s_setprio(0); } while (0)
#define PG8_WAIT_V(n) asm volatile("s_waitcnt vmcnt(" #n ")" ::: "memory")
#define PG8_WAIT_L(n) asm volatile("s_waitcnt lgkmcnt(" #n ")" ::: "memory")
#define PG8_BAR __builtin_amdgcn_s_barrier()
#define PG8_SCHED __builtin_amdgcn_sched_barrier(0)
    Unit cur, nxt; int ui = 0;
    if (!S.next(0, cur)) return;
    typedef typename Epi::acc_t acc_t;
    acc_t acc[2][2][4][2];
#pragma unroll
    for (int a = 0; a < 2; ++a)
#pragma unroll
        for (int b = 0; b < 2; ++b)
#pragma unroll
            for (int m = 0; m < 4; ++m)
#pragma unroll
                for (int n = 0; n < 2; ++n) acc[a][b][m][n] = acc_t{};
    bf16x8 At[4][2], B0[2][2], B1[2][2];
    const char* cA = (const char*)g.A + (size_t)cur.pm * tstepA + (size_t)cur.kt0 * kstepA; const char* cB = (const char*)g.Bt + (size_t)cur.pn * tstepB + (size_t)cur.kt0 * kstepB;
    S.a_ready(cur);
    typename Epi::Pre pre; E.prefetch(pre, cur, wr, wc, fr, fq);
    if constexpr (SP2) {
        PG8_STAGE(PG8_SB(0, 0), cB, voffB); PG8_STAGE(PG8_SB(0, 1), cB + hstepB, voffB); PG8_STAGE(PG8_SA(0, 0), cA, voffA); PG8_STAGE(PG8_SA(0, 1), cA + hstepA, voffA);
        if (wr == 1) PG8_BAR;
        PG8_WAIT_V(2); PG8_BAR;
        PG8_STAGE(PG8_SB(1, 0), cB + kstepB, voffB); PG8_STAGE(PG8_SA(1, 0), cA + kstepA, voffA); PG8_STAGE(PG8_SB(1, 1), cB + hstepB + kstepB, voffB);
        PG8_WAIT_V(6); PG8_BAR;
    } else {
        PG8_STAGE(PG8_SB(0, 0), cB, voffB); PG8_STAGE(PG8_SA(0, 0), cA, voffA); PG8_STAGE(PG8_SB(0, 1), cB + hstepB, voffB); PG8_STAGE(PG8_SA(0, 1), cA + hstepA, voffA);
        if (wr == 1) PG8_BAR;
        PG8_WAIT_V(4); PG8_BAR;
        PG8_STAGE(PG8_SB(1, 0), cB + kstepB, voffB); PG8_STAGE(PG8_SA(1, 0), cA + kstepA, voffA); PG8_STAGE(PG8_SB(1, 1), cB + hstepB + kstepB, voffB);
        PG8_WAIT_V(6); PG8_BAR;
    }
    for (;;) {
        const bool has_next = S.next(ui + 1, nxt);
        const char* nA = has_next ? (const char*)g.A + (size_t)nxt.pm * tstepA + (size_t)nxt.kt0 * kstepA : cA; const char* nB = has_next ? (const char*)g.Bt + (size_t)nxt.pn * tstepB + (size_t)nxt.kt0 * kstepB : cB;
        const int nt = cur.nkt;
        for (int t = 0; t < nt; t += 2) {
            if constexpr (Epi::L2PF) { if (t == nt - 4) E.l2pf(cur, wid, lane, lds + 135168); }
            const bool last = (t == nt - 2);
            const char* a1 = cA + (size_t)(t + 1) * kstepA;
            const char* a2 = last ? nA : cA + (size_t)(t + 2) * kstepA; const char* b2 = last ? nB : cB + (size_t)(t + 2) * kstepB;
            const char* a3 = a2 + kstepA; const char* b3 = b2 + kstepB;
            if (last && has_next) S.a_ready(nxt);
            if constexpr (SP2) {
            PG8_LDB(B0, 0, 0); PG8_LDB(B1, 0, 1); PG8_SCHED; PG8_LDA(At, 0, 0); PG8_STAGE(PG8_SA(1, 1), a1 + hstepA, voffA);
            PG8_WAIT_V(8); PG8_WAIT_L(0); PG8_BAR; PG8_MMA(0, 0, At, B0); PG8_MMA(0, 1, At, B1); PG8_BAR; PG8_SCHED;
            PG8_LDA(At, 0, 1); PG8_STAGE(PG8_SB(0, 0), b2, voffB); PG8_STAGE(PG8_SB(0, 1), b2 + hstepB, voffB); PG8_STAGE(PG8_SA(0, 0), a2, voffA);
            PG8_WAIT_V(8); PG8_WAIT_L(0); PG8_BAR; PG8_MMA(1, 0, At, B0); PG8_MMA(1, 1, At, B1); PG8_BAR; PG8_SCHED;
            PG8_LDB(B0, 1, 0); PG8_LDB(B1, 1, 1); PG8_SCHED; PG8_LDA(At, 1, 0); PG8_STAGE(PG8_SA(0, 1), a2 + hstepA, voffA);
            PG8_WAIT_V(8); PG8_WAIT_L(0); PG8_BAR; PG8_MMA(0, 0, At, B0); PG8_MMA(0, 1, At, B1); PG8_BAR; PG8_SCHED;
            PG8_LDA(At, 1, 1); PG8_STAGE(PG8_SB(1, 0), b3, voffB); PG8_STAGE(PG8_SB(1, 1), b3 + hstepB, voffB); PG8_STAGE(PG8_SA(1, 0), a3, voffA);
            PG8_WAIT_V(8); PG8_WAIT_L(0); PG8_BAR; PG8_MMA(1, 0, At, B0); PG8_MMA(1, 1, At, B1); PG8_BAR; PG8_SCHED;
            } else {
            PG8_LDB(B0, 0, 0); PG8_SCHED; PG8_LDA(At, 0, 0); PG8_STAGE(PG8_SA(1, 1), a1 + hstepA, voffA);
            PG8_WAIT_L(8); PG8_BAR; PG8_WAIT_L(0); PG8_MMA(0, 0, At, B0); PG8_BAR; PG8_SCHED;
            PG8_LDB(B1, 0, 1); PG8_STAGE(PG8_SB(0, 0), b2, voffB);
            PG8_BAR; PG8_WAIT_L(0); PG8_MMA(0, 1, At, B1); PG8_BAR;
            PG8_LDA(At, 0, 1); PG8_STAGE(PG8_SA(0, 0), a2, voffA);
            PG8_BAR; PG8_WAIT_L(0); PG8_MMA(1, 0, At, B0); PG8_BAR; PG8_SCHED;
            PG8_STAGE(PG8_SB(0, 1), b2 + hstepB, voffB);
            PG8_WAIT_V(6); PG8_BAR; PG8_MMA(1, 1, At, B1); PG8_BAR;
            PG8_LDB(B0, 1, 0); PG8_SCHED; PG8_LDA(At, 1, 0); PG8_STAGE(PG8_SA(0, 1), a2 + hstepA, voffA);
            PG8_WAIT_L(8); PG8_BAR; PG8_WAIT_L(0); PG8_MMA(0, 0, At, B0); PG8_BAR; PG8_SCHED;
            PG8_LDB(B1, 1, 1); PG8_STAGE(PG8_SB(1, 0), b3, voffB);
            PG8_BAR; PG8_WAIT_L(0); PG8_MMA(0, 1, At, B1); PG8_BAR;
            PG8_LDA(At, 1, 1); PG8_STAGE(PG8_SA(1, 0), a3, voffA);
            PG8_BAR; PG8_WAIT_L(0); PG8_MMA(1, 0, At, B0); PG8_BAR; PG8_SCHED;
            PG8_STAGE(PG8_SB(1, 1), b3 + hstepB, voffB);
            PG8_WAIT_V(6); PG8_BAR; PG8_MMA(1, 1, At, B1); PG8_BAR;
            }
        }
        if constexpr (ALIGN_EPI) { if (wr == 0) PG8_BAR; }
        if constexpr (!Epi::AFTER_DRAIN) { E(acc, cur, wr, wc, fr, fq, pre); S.done(cur); }
        if (!has_next) break;
#pragma unroll
        for (int a = 0; a < 2; ++a)
#pragma unroll
            for (int b = 0; b < 2; ++b)
#pragma unroll
                for (int m = 0; m < 4; ++m)
#pragma unroll
                    for (int n = 0; n < 2; ++n) acc[a][b][m][n] = acc_t{};
        cur = nxt; cA = nA; cB = nB; ++ui;
        E.prefetch(pre, cur, wr, wc, fr, fq);
        if constexpr (ALIGN_EPI) { if (wr == 1) PG8_BAR; }
    }
    PG8_WAIT_V(0);
    if constexpr (!ALIGN_EPI) { if (wr == 0) PG8_BAR; }
    PG8_BAR;
    if constexpr (Epi::AFTER_DRAIN) { E.fused(acc, cur, wr, wc, fr, fq, lds, wid, lane); S.done(cur); }
#undef PG8_SA
#undef PG8_SB
#undef PG8_STAGE
#undef PG8_LDA
#undef PG8_LDB
#undef PG8_MMA
#undef PG8_WAIT_V
#undef PG8_WAIT_L
#undef PG8_BAR
#undef PG8_SCHED
}
}
constexpr int NWAVES = 8;
constexpr int DM = 2048, NBATCH = 4, SEQL = 4096, CTXL = 256, FF = 5504, FF2 = 11008;
constexpr int ML = NBATCH * SEQL, MC = NBATCH * CTXL, MT = ML + MC;
constexpr int ABN = 3584, NAN3 = 6144, MODW = 9 * DM;
constexpr float EPSN = 1e-6f;
constexpr float ATT_SCALE = 0.088388347648318440f;
#ifndef NPHASES_RUN
#define NPHASES_RUN 22
#endif
constexpr int N_PHASES = 22;
constexpr int HQP = 5632;
#ifndef GEMM_ALIGN
#define GEMM_ALIGN true
#endif
#ifndef G1_ALIGN
#define G1_ALIGN GEMM_ALIGN
#endif
#ifndef G2_ALIGN
#define G2_ALIGN GEMM_ALIGN
#endif
#ifndef G1_WGM
#define G1_WGM 4
#endif
#ifndef G2_WGM
#define G2_WGM 4
#endif
#ifndef HID_CLIP
#define HID_CLIP 1.0f
#endif
#ifndef P0_NPRO
#define P0_NPRO 3
#endif
#ifndef LRU_EXTRA
#define LRU_EXTRA 4
#endif
#ifndef NORM_LA
#define NORM_LA 4
#endif
#ifndef GEMM_SP2
#define GEMM_SP2 true
#endif

constexpr size_t MiB = 1u << 20;
constexpr size_t WS_CTL = 0, CTL_ZERO_BYTES = 1 * MiB;
constexpr size_t WS_MOD = 1 * MiB;
constexpr size_t WS_ROPE = 2 * MiB;
constexpr size_t WS_QKG = 2 * MiB + 65536;
constexpr size_t WS_CARRY = 3 * MiB;
constexpr size_t WS_HIN = 9 * MiB;
constexpr size_t WS_SH = 12 * MiB;
constexpr size_t WS_SQ = 13 * MiB;
constexpr size_t WS_SY = 14 * MiB;
constexpr size_t WS_WLRU = 8 * MiB;
constexpr size_t WS_WFI = 16 * MiB;
constexpr size_t WS_WFO = 188 * MiB;
constexpr size_t WS_WABI = 274 * MiB, WS_WABO = 288 * MiB, WS_WNAI = 296 * MiB, WS_WNAO = 320 * MiB;
constexpr size_t WS_X = 328 * MiB;
constexpr size_t WS_H = 464 * MiB;
constexpr size_t WS_BIG = 532 * MiB;
constexpr size_t WS_D = 788 * MiB;
constexpr size_t WS_END = 884 * MiB;
static_assert(WS_WFI + 4ull * FF2 * DM * 2 <= WS_WFO && WS_WFO + 4ull * DM * FF * 2 <= WS_WABI && WS_WABI + (size_t)ABN * DM * 2 <= WS_WABO && WS_WNAI + (size_t)NAN3 * DM * 2 <= WS_WNAO, "ws map (weights)");
static_assert(WS_X + (size_t)MT * DM * 4 <= WS_H && WS_H + (size_t)MT * DM * 2 <= WS_BIG && WS_BIG + (size_t)MT * NAN3 * 2 <= WS_D && WS_D + 44ull * MT * 128 <= WS_END, "ws map (activations)");
constexpr int CW_BAR = 4096;
constexpr size_t CTL_WMAX_IN = 64 * 1024, CTL_WMAX_OUT = CTL_WMAX_IN + 4 * FF2 * 4;
constexpr size_t CTL_WMAX_NAI = CTL_WMAX_OUT + 4 * DM * 4, CTL_WMAX_NAO = CTL_WMAX_NAI + NAN3 * 4;
static_assert(CTL_WMAX_NAO + DM * 4 <= 512 * 1024, "CTL map");

constexpr int RING_BYTES = 131072;
constexpr int LDSCTL_OFF = RING_BYTES, MISC_OFF = LDSCTL_OFF + 320;
constexpr int LDS_BYTES = 163840;
constexpr int LRU_U_OFF = RING_BYTES + 4096;

#define GAS __attribute__((address_space(1)))
#define LAS __attribute__((address_space(3)))
typedef unsigned short bf16;
typedef float f32x4 __attribute__((ext_vector_type(4)));
typedef float f32x2 __attribute__((ext_vector_type(2)));
typedef float f32x16 __attribute__((ext_vector_type(16)));
typedef short bf16x8 __attribute__((ext_vector_type(8)));
typedef short s16x4 __attribute__((ext_vector_type(4)));
typedef unsigned u32x4 __attribute__((ext_vector_type(4)));
typedef unsigned u32x2 __attribute__((ext_vector_type(2)));
#define RLX_AGENT __ATOMIC_RELAXED, __HIP_MEMORY_SCOPE_AGENT
#define LDS_WAIT() asm volatile("s_waitcnt lgkmcnt(0)" ::: "memory")
#define LDS_BARRIER() do { asm volatile("s_waitcnt lgkmcnt(0)" ::: "memory"); __builtin_amdgcn_s_barrier(); asm volatile("" ::: "memory"); } while (0)
__device__ __forceinline__ unsigned cvtpk(float lo, float hi) { unsigned r; asm volatile("v_cvt_pk_bf16_f32 %0, %1, %2" : "=v"(r) : "v"(lo), "v"(hi)); return r; }
__device__ __forceinline__ float bflo(unsigned w) { return __uint_as_float(w << 16); }
__device__ __forceinline__ float bfhi(unsigned w) { return __uint_as_float(w & 0xffff0000u); }
__device__ __forceinline__ unsigned short f2bf(float f) { return (unsigned short)(cvtpk(f, f) & 0xffffu); }
__device__ __forceinline__ void unpack8(const u32x4 w, float (&x)[8]) { x[0] = bflo(w.x); x[1] = bfhi(w.x); x[2] = bflo(w.y); x[3] = bfhi(w.y); x[4] = bflo(w.z); x[5] = bfhi(w.z); x[6] = bflo(w.w); x[7] = bfhi(w.w); }
__device__ __forceinline__ u32x4 pack8(const float (&x)[8]) { u32x4 w; w.x = cvtpk(x[0], x[1]); w.y = cvtpk(x[2], x[3]); w.z = cvtpk(x[4], x[5]); w.w = cvtpk(x[6], x[7]); return w; }
__device__ __forceinline__ float sigmoid_f(float x) { return __builtin_amdgcn_rcpf(1.0f + __builtin_amdgcn_exp2f(-1.4426950408889634f * x)); }
template <int M> __device__ __forceinline__ float swz_xor(float v) { return __int_as_float(__builtin_amdgcn_ds_swizzle(__float_as_int(v), (M << 10) | 0x1f)); }
__device__ __forceinline__ float half_sum(float v) { auto rr = __builtin_amdgcn_permlane32_swap(__float_as_uint(v), __float_as_uint(v), false, false); return __uint_as_float(rr[0]) + __uint_as_float(rr[1]); }
__device__ __forceinline__ float wave_max(float v) { v = fmaxf(v, swz_xor<1>(v)); v = fmaxf(v, swz_xor<2>(v)); v = fmaxf(v, swz_xor<4>(v)); v = fmaxf(v, swz_xor<8>(v)); v = fmaxf(v, swz_xor<16>(v));
    auto rr = __builtin_amdgcn_permlane32_swap(__float_as_uint(v), __float_as_uint(v), false, false); return fmaxf(__uint_as_float(rr[0]), __uint_as_float(rr[1])); }
__device__ __forceinline__ unsigned pack_i8x4(f32x4 y, float inv) {
    const f32x4 t = y * inv + 12582912.0f;
    const unsigned lo = __builtin_amdgcn_perm(__float_as_uint(t.y), __float_as_uint(t.x), 0x0c0c0400u), hi = __builtin_amdgcn_perm(__float_as_uint(t.w), __float_as_uint(t.z), 0x04000c0cu);
    return lo | hi; }
__device__ __forceinline__ float wave_sum(float v) { v += swz_xor<1>(v); v += swz_xor<2>(v); v += swz_xor<4>(v); v += swz_xor<8>(v); v += swz_xor<16>(v); return half_sum(v); }
#define XB_TMO      128
#define XB_XCNT(j)  (256  + 64 * (j))
#define XB_XSUB(j)  (1280 + 64 * (j))
#define XB_XGEN(j)  (2304 + 64 * (j))
#define XB_TOP      3328
#define XB_TOPGEN   3392
#define XCD_BAR_WORDS 3456
#define XB_SPIN_CAP (1u << 18)

__device__ __forceinline__ unsigned xb_ld(unsigned* p)              { return __hip_atomic_load(p, __ATOMIC_RELAXED, __HIP_MEMORY_SCOPE_AGENT); }
__device__ __forceinline__ unsigned xb_add(unsigned* p, unsigned v) { return __hip_atomic_fetch_add(p, v, __ATOMIC_RELAXED, __HIP_MEMORY_SCOPE_AGENT); }
__device__ __forceinline__ unsigned xb_xcc_id() { return (unsigned)__builtin_amdgcn_s_getreg((3 << 11) | 20) & 0xFu; }
#define XB_SPIN(cond, bar) do { unsigned _sp = 0; while (cond) { __builtin_amdgcn_s_sleep(1); \
    if ((++_sp & 255u) == 0u) { if (xb_ld(&(bar)[XB_TMO])) break; if (_sp > XB_SPIN_CAP) { atomicAdd(&(bar)[XB_TMO], 1u); break; } } } } while (0)

struct XcdBarrier {
    unsigned* bar; unsigned x;
    volatile LAS unsigned* st;
};

__device__ __forceinline__ XcdBarrier xcd_barrier_post(unsigned* bar, volatile LAS unsigned* st) {
    XcdBarrier b; b.bar = bar; b.x = xb_xcc_id(); b.st = st;
    if (threadIdx.x == 0) (void)xb_add(&bar[XB_XCNT(b.x)], 1u);
    return b;
}
__device__ __forceinline__ void xcd_barrier_complete(unsigned* bar, unsigned x, unsigned& nloc, unsigned& nx) {
    const unsigned G = gridDim.x * gridDim.y * gridDim.z;
    unsigned sum, cnt, mine, sp = 0u;
    for (;;) {
        sum = 0u; cnt = 0u; mine = 0u;
#pragma unroll
        for (unsigned j = 0; j < 16; ++j) { const unsigned c = xb_ld(&bar[XB_XCNT(j)]); sum += c; cnt += (c > 0u) ? 1u : 0u; mine = (j == x) ? c : mine; }
        if (sum == G) break;
        __builtin_amdgcn_s_sleep(1);
        if ((++sp & 255u) == 0u) { if (xb_ld(&bar[XB_TMO])) break; if (sp > XB_SPIN_CAP) { atomicAdd(&bar[XB_TMO], 1u); break; } }
    }
    nloc = mine > 0u ? mine : 1u; nx = cnt > 0u ? cnt : 1u;
}

__device__ __forceinline__ void xcd_barrier(const XcdBarrier& b) {
    asm volatile("s_waitcnt vmcnt(0)" ::: "memory");
    __syncthreads();
    if (threadIdx.x == 0) {
        unsigned* bar = b.bar; asm volatile("" : "+s"(bar));
        __builtin_amdgcn_s_waitcnt(0);
        unsigned nloc = b.st[0], nx = b.st[1];
        if (nloc == 0u) { xcd_barrier_complete(bar, b.x, nloc, nx); b.st[0] = nloc; b.st[1] = nx; }
        const unsigned old = xb_add(&bar[XB_XSUB(b.x)], 1u);
        const unsigned gen = old / nloc;
        if (old + 1u == (gen + 1u) * nloc) {
            __builtin_amdgcn_fence(__ATOMIC_RELEASE, "agent");
            asm volatile("s_waitcnt vmcnt(0)" ::: "memory");
            const unsigned og = xb_add(&bar[XB_TOP], 1u);
            const unsigned tg = og / nx;
            if (og + 1u == (tg + 1u) * nx) xb_add(&bar[XB_TOPGEN], 1u);
            else XB_SPIN(xb_ld(&bar[XB_TOPGEN]) == tg, bar);
            __builtin_amdgcn_fence(__ATOMIC_ACQUIRE, "agent");
            xb_add(&bar[XB_XGEN(b.x)], 1u);
            asm volatile("s_waitcnt vmcnt(0)" ::: "memory");
        } else {
            XB_SPIN(xb_ld(&bar[XB_XGEN(b.x)]) == gen, bar);
            __builtin_amdgcn_fence(__ATOMIC_ACQUIRE, "agent");
            asm volatile("s_waitcnt vmcnt(0)" ::: "memory");
        }
    }
    __syncthreads();
}
struct Args { const float* in[26]; float* out; unsigned char* ws; int ph_lo, ph_hi; };
enum { IN_X = 0, IN_C, IN_CTX, IN_CCTX, IN_WMOD, IN_BMOD, IN_NORMG, IN_FWI, IN_FWO, IN_ABWI, IN_CONVW, IN_CONVB, IN_LWA, IN_LBA, IN_LWX, IN_LBX, IN_LAM,
       IN_AQN, IN_AKN, IN_SINK, IN_ABWO, IN_NAWI, IN_NAQN, IN_NAKN, IN_RPB, IN_NAWO };

__device__ __forceinline__ void p0_transpose_item(const float* W, int ldw, int K, bf16* WT, int dst_row0, int src_col0, int k0, LAS float* scr, int lane, int tm_rows = 0) {
    { f32x4 t4[8];
#pragma unroll
      for (int i = 0; i < 8; ++i) t4[i] = *(const f32x4*)(W + (size_t)(k0 + 8 * i + (lane >> 3)) * ldw + src_col0 + 4 * (lane & 7));
#pragma unroll
      for (int i = 0; i < 8; ++i) { LAS float* sp = scr + (8 * i + (lane >> 3)) * 33 + 4 * (lane & 7); sp[0] = t4[i].x; sp[1] = t4[i].y; sp[2] = t4[i].z; sp[3] = t4[i].w; } }
    LDS_WAIT();
    const int c = lane & 7;
#pragma unroll
    for (int j = 0; j < 4; ++j) { const int n = (lane >> 3) + 8 * j; const LAS float* s = scr + (8 * c) * 33 + n;
        u32x4 o; o.x = cvtpk(s[0 * 33], s[1 * 33]); o.y = cvtpk(s[2 * 33], s[3 * 33]); o.z = cvtpk(s[4 * 33], s[5 * 33]); o.w = cvtpk(s[6 * 33], s[7 * 33]);
        bf16* dp = tm_rows ? WT + ((size_t)(k0 >> 6) * tm_rows + dst_row0 + n) * 64 + 8 * c : WT + (size_t)(dst_row0 + n) * K + k0 + 8 * c;
        *(u32x4*)dp = o; }
    LDS_WAIT();
}
__device__ __forceinline__ void p0_absmax_phase(const Args& a, int tid, int vc, int VG, int set) {
    asm volatile("" : "+v"(tid)); const int lane = tid & 63, wave = __builtin_amdgcn_readfirstlane(tid >> 6);
    unsigned* wmax_in = (unsigned*)(a.ws + WS_CTL + CTL_WMAX_IN); unsigned* wmax_out = (unsigned*)(a.ws + WS_CTL + CTL_WMAX_OUT);
    constexpr int I_IN = 43 * 16, I_OUT = 8 * 43, I_NAI = 24 * 16, I_NAO = 8 * 16;
    const int nloc = set < 4 ? I_IN + I_OUT : I_NAI + I_NAO;
    for (int il = vc * NWAVES + wave; il < nloc; il += VG * NWAVES) {
        const int it = set < 4 ? (il < I_IN ? set * I_IN + il : 4 * I_IN + set * I_OUT + (il - I_IN)) : 4 * (I_IN + I_OUT) + il;
        const float* W; int ldw, c0, k0; unsigned* dst;
        if (it < 4 * I_IN) { const int m = it / I_IN, q = it % I_IN; c0 = (q % 43) * 256; k0 = (q / 43) * 128; ldw = FF2; W = a.in[IN_FWI] + (size_t)m * DM * FF2; dst = wmax_in + m * FF2 + c0; }
        else if (it < 4 * (I_IN + I_OUT)) { const int r = it - 4 * I_IN, m = r / I_OUT, q = r % I_OUT; c0 = (q % 8) * 256; k0 = (q / 8) * 128; ldw = DM; W = a.in[IN_FWO] + (size_t)m * FF * DM; dst = wmax_out + m * DM + c0; }
        else if (it < 4 * (I_IN + I_OUT) + I_NAI) { const int q = it - 4 * (I_IN + I_OUT); c0 = (q % 24) * 256; k0 = (q / 24) * 128; ldw = NAN3; W = a.in[IN_NAWI]; dst = (unsigned*)(a.ws + WS_CTL + CTL_WMAX_NAI) + c0; }
        else { const int q = it - 4 * (I_IN + I_OUT) - I_NAI; c0 = (q % 8) * 256; k0 = (q / 8) * 128; ldw = DM; W = a.in[IN_NAWO]; dst = (unsigned*)(a.ws + WS_CTL + CTL_WMAX_NAO) + c0; }
        const float* wp = W + (size_t)k0 * ldw + c0 + lane * 4; f32x4 mx = (f32x4){0.f, 0.f, 0.f, 0.f};
#pragma unroll 16
        for (int i = 0; i < 128; ++i) { const f32x4 v = *(const f32x4*)(wp + (size_t)i * ldw); mx.x = fmaxf(mx.x, fabsf(v.x)); mx.y = fmaxf(mx.y, fabsf(v.y)); mx.z = fmaxf(mx.z, fabsf(v.z)); mx.w = fmaxf(mx.w, fabsf(v.w)); }
        atomicMax(dst + lane * 4 + 0, __float_as_uint(mx.x)); atomicMax(dst + lane * 4 + 1, __float_as_uint(mx.y)); atomicMax(dst + lane * 4 + 2, __float_as_uint(mx.z)); atomicMax(dst + lane * 4 + 3, __float_as_uint(mx.w));
    }
}
__device__ __forceinline__ void p0_quant_item(const float* W, int ldw, int Kp, signed char* WT, int dst_row0, int src_col0, int k0, const float* wmax, LAS float* scr, int lane) {
    { f32x4 t4[8];
#pragma unroll
      for (int i = 0; i < 8; ++i) t4[i] = *(const f32x4*)(W + (size_t)(k0 + 8 * i + (lane >> 3)) * ldw + src_col0 + 4 * (lane & 7));
#pragma unroll
      for (int i = 0; i < 8; ++i) { LAS float* sp = scr + (8 * i + (lane >> 3)) * 33 + 4 * (lane & 7); sp[0] = t4[i].x; sp[1] = t4[i].y; sp[2] = t4[i].z; sp[3] = t4[i].w; } }
    LDS_WAIT();
    const int c = lane & 7;
#pragma unroll
    for (int j = 0; j < 4; ++j) { const int n = (lane >> 3) + 8 * j; const LAS float* s = scr + (8 * c) * 33 + n; const float inv = 127.0f / fmaxf(wmax[src_col0 + n], 1e-30f);
        int qv[8];
#pragma unroll
        for (int e = 0; e < 8; ++e) { int v = (int)rintf(s[e * 33] * inv); v = v > 127 ? 127 : (v < -127 ? -127 : v); qv[e] = v & 255; }
        u32x2 o; o.x = (unsigned)(qv[0] | (qv[1] << 8) | (qv[2] << 16) | (qv[3] << 24)); o.y = (unsigned)(qv[4] | (qv[5] << 8) | (qv[6] << 16) | (qv[7] << 24));
        *(u32x2*)(WT + (size_t)(dst_row0 + n) * Kp + k0 + 8 * c) = o; }
    LDS_WAIT();
}
__device__ __forceinline__ void p0_quant_item_tm(const float* W, int ldw, int nrows, signed char* WT, int dst_row0, int src_col0, int k0, const float* wmax, LAS float* scr, int lane) {
    { f32x4 t4[8];
#pragma unroll
      for (int i = 0; i < 8; ++i) t4[i] = *(const f32x4*)(W + (size_t)(k0 + 8 * i + (lane >> 3)) * ldw + src_col0 + 4 * (lane & 7));
#pragma unroll
      for (int i = 0; i < 8; ++i) { LAS float* sp = scr + (8 * i + (lane >> 3)) * 33 + 4 * (lane & 7); sp[0] = t4[i].x; sp[1] = t4[i].y; sp[2] = t4[i].z; sp[3] = t4[i].w; } }
    LDS_WAIT();
    const int c = lane & 7;
#pragma unroll
    for (int j = 0; j < 4; ++j) { const int n = (lane >> 3) + 8 * j; const LAS float* s = scr + (8 * c) * 33 + n; const float inv = 127.0f / fmaxf(wmax[src_col0 + n], 1e-30f);
        int qv[8];
#pragma unroll
        for (int e = 0; e < 8; ++e) { int v = (int)rintf(s[e * 33] * inv); v = v > 127 ? 127 : (v < -127 ? -127 : v); qv[e] = v & 255; }
        u32x2 o; o.x = (unsigned)(qv[0] | (qv[1] << 8) | (qv[2] << 16) | (qv[3] << 24)); o.y = (unsigned)(qv[4] | (qv[5] << 8) | (qv[6] << 16) | (qv[7] << 24));
        *(u32x2*)(WT + ((size_t)(k0 >> 7) * nrows + dst_row0 + n) * 128 + (k0 & 127) + 8 * c) = o; }
    LDS_WAIT();
}
struct P0Item { const float* src; const float* wmx; unsigned char* dst; int ldw, dpitch, perm; };
__device__ __forceinline__ void p0_misc(const Args& a, LAS unsigned char* lds, int tid, int lane, int wave, int G) {
    asm volatile("" : "+v"(tid)); lane = tid & 63; wave = __builtin_amdgcn_readfirstlane(tid >> 6);
    unsigned char* ws = a.ws;
    LAS float* SC = (LAS float*)(lds + 69632);
    LAS float* RED = (LAS float*)(lds + 110592);
    {
    for (int i = tid; i < 5 * DM; i += NWAVES * 64) { const float v = i < 4 * DM ? a.in[IN_C][i] : a.in[IN_CCTX][i - 4 * DM]; SC[i] = v * sigmoid_f(v); }
    __syncthreads();
    float* MOD = (float*)(ws + WS_MOD);
    for (int it = blockIdx.x; it < 2 * 576; it += G) {
        const int l = it / 576, col0 = (it % 576) * 32;
        const float* wp = a.in[IN_WMOD] + (size_t)l * DM * MODW + col0 + (lane & 7) * 4;
        f32x4 acc[5];
#pragma unroll
        for (int b = 0; b < 5; ++b) acc[b] = (f32x4){0.f, 0.f, 0.f, 0.f};
        const int kb = wave * 256 + (lane >> 3);
#pragma unroll
        for (int h = 0; h < 2; ++h) { f32x4 wv[16];
#pragma unroll
            for (int i = 0; i < 16; ++i) wv[i] = *(const f32x4*)(wp + (size_t)(kb + (16 * h + i) * 8) * MODW);
            if (h == 0) __builtin_amdgcn_sched_barrier(0);
#pragma unroll
            for (int i = 0; i < 16; ++i) { const int k = kb + (16 * h + i) * 8;
#pragma unroll
                for (int b = 0; b < 5; ++b) acc[b] += SC[b * DM + k] * wv[i]; } }
#pragma unroll
        for (int b = 0; b < 5; ++b)
#pragma unroll
            for (int j = 0; j < 4; ++j) { float v = acc[b][j]; v += swz_xor<8>(v); v += swz_xor<16>(v); v = half_sum(v); acc[b][j] = v; }
        if (lane < 8) {
#pragma unroll
            for (int b = 0; b < 5; ++b) *(LAS f32x4*)(RED + (wave * 5 + b) * 32 + lane * 4) = acc[b]; }
        __syncthreads();
        if (tid < 160) { const int b = tid >> 5, cc = tid & 31; float s = a.in[IN_BMOD][l * MODW + col0 + cc];
#pragma unroll
            for (int w = 0; w < 8; ++w) s += RED[(w * 5 + b) * 32 + cc];
            MOD[(size_t)(l * 5 + b) * MODW + col0 + cc] = s; }
        __syncthreads();
    }
    if (blockIdx.x == 0) {
        f32x2* ROPE = (f32x2*)(ws + WS_ROPE);
        for (int i = tid; i < 64 * 32; i += NWAVES * 64) { const int pos = i >> 5, f = i & 31;
            const float inv = exp2f(-(float)f * (13.287712379549449f / 32.0f)); const float ang = (float)pos * inv;
            const double rev = (double)ang * 0.15915494309189535; const float fr = (float)(rev - __builtin_rint(rev));
            ROPE[i] = (f32x2){__builtin_amdgcn_cosf(fr), __builtin_amdgcn_sinf(fr)}; }
        if (tid < 256) { const int hd = tid & 127, p = hd & 63; ((float*)(ws + WS_QKG))[tid] = (tid < 128 ? a.in[IN_AQN] : a.in[IN_AKN])[(hd & 64) + (p & 1) * 32 + (p >> 1)]; }
    }
    }
}
constexpr int P0_I_FI = 32 * 344, P0_I_FO = 86 * 64, P0_I_ABI = 32 * 112, P0_I_ABO = 32 * 64, P0_I_NAI = 32 * 192, P0_I_NAO = 32 * 64, P0_I_LRU = 32 * 8;
__host__ __device__ constexpr int p0_nitems(int set) { return set < 0 ? P0_I_ABI + P0_I_ABO + P0_I_LRU : (set < 4 ? P0_I_FI + P0_I_FO : P0_I_NAI + P0_I_NAO); }
__device__ __forceinline__ void p0_convert(const Args& a, LAS unsigned char* lds, int tid, int vc, int VG, int set, int lo, int hi) {
    asm volatile("" : "+v"(tid)); const int lane = tid & 63, wave = __builtin_amdgcn_readfirstlane(tid >> 6);
    unsigned char* ws = a.ws;
    LAS float* scr = (LAS float*)(lds + wave * 8704);
    constexpr int I_FI = P0_I_FI, I_ABI = P0_I_ABI, I_ABO = P0_I_ABO, I_NAI = P0_I_NAI;
    const int gw = lo + vc * NWAVES + wave, NGW = VG * NWAVES, nloc = hi;
    if (set >= 0 && set < 4 && hi > I_FI) {
        unsigned char* z = ws + WS_WFO + (size_t)set * DM * HQP + FF;
        u32x4 z0 = (u32x4){0u, 0u, 0u, 0u}; asm volatile("" : "+v"(z0));
        for (int i = vc * (NWAVES * 64) + tid; i < DM * 8; i += VG * NWAVES * 64) *(u32x4*)(z + (size_t)(i >> 3) * HQP + (i & 7) * 16) = z0; }
    if (gw < nloc) {
        const float* dummy = (const float*)(ws + WS_CTL);
        auto decode = [&](int il, P0Item& d) {
            d.perm = 0;
            if (set < 0) {
                if (il < I_ABI) { const int kb = il / 112, nb = il % 112; d.src = a.in[IN_ABWI] + (size_t)kb * 64 * ABN + nb * 32; d.ldw = ABN; d.dst = ws + WS_WABI + ((size_t)nb * 32 * DM + kb * 64) * 2; d.dpitch = DM * 2;
                    if (nb >= 64 && nb < 104) { const int w = nb & 3; d.perm = 1; d.src = a.in[IN_ABWI] + (size_t)kb * 64 * ABN + (nb & ~3) * 32 + (w >> 1) * 64 + (w & 1) * 16; } }
                else if (il < I_ABI + I_ABO) { const int r = il - I_ABI, kb = r / 64, nb = r % 64; d.src = a.in[IN_ABWO] + (size_t)kb * 64 * DM + nb * 32; d.ldw = DM; d.dst = ws + WS_WABO + ((size_t)nb * 32 * DM + kb * 64) * 2; d.dpitch = DM * 2; }
                else { const int r = il - I_ABI - I_ABO, mm = r >> 3, qq = r & 7, which = mm >> 4, dir = (mm >> 3) & 1, blk = mm & 7, kb = qq >> 2, nb = qq & 3;
                    d.src = (which ? a.in[IN_LWX] : a.in[IN_LWA]) + (size_t)(dir * 8 + blk) * 128 * 128 + kb * 64 * 128 + nb * 32; d.ldw = 128;
                    d.dst = ws + WS_WLRU + ((size_t)((dir * 2 + which) * 8 + blk) * 128 * 128 + nb * 32 * 128 + kb * 64) * 2; d.dpitch = 256; }
                d.wmx = dummy;
            } else if (set < 4) {
                if (il < I_FI) { const int kb = il / 344, nb = il % 344, R0 = nb * 32, tile = R0 >> 8, wi = R0 & 255, sc0 = wi < 128 ? tile * 128 + wi : FF + tile * 128 + (wi - 128);
                    d.src = a.in[IN_FWI] + (size_t)set * DM * FF2 + (size_t)kb * 64 * FF2 + sc0; d.ldw = FF2; d.wmx = (const float*)(ws + WS_CTL + CTL_WMAX_IN) + set * FF2 + sc0;
                    d.dst = ws + WS_WFI + (size_t)set * FF2 * DM + (size_t)R0 * DM + kb * 64; d.dpitch = DM; }
                else { const int r = il - I_FI, kb = r / 64, nb = r % 64;
                    d.src = a.in[IN_FWO] + (size_t)set * FF * DM + (size_t)kb * 64 * DM + nb * 32; d.ldw = DM; d.wmx = (const float*)(ws + WS_CTL + CTL_WMAX_OUT) + set * DM + nb * 32;
                    d.dst = ws + WS_WFO + (size_t)set * DM * HQP + (size_t)(nb * 32) * HQP + kb * 64; d.dpitch = HQP; }
            } else {
                if (il < I_NAI) { const int kb = il / 192, nb = il % 192; d.src = a.in[IN_NAWI] + (size_t)kb * 64 * NAN3 + nb * 32; d.ldw = NAN3; d.wmx = (const float*)(ws + WS_CTL + CTL_WMAX_NAI) + nb * 32;
                    d.dst = ws + WS_WNAI + (size_t)nb * 32 * DM + kb * 64; d.dpitch = DM; }
                else { const int r = il - I_NAI, kb = r / 64, nb = r % 64; d.src = a.in[IN_NAWO] + (size_t)kb * 64 * DM + nb * 32; d.ldw = DM; d.wmx = (const float*)(ws + WS_CTL + CTL_WMAX_NAO) + nb * 32;
                    d.dst = ws + WS_WNAO + (size_t)nb * 32 * DM + kb * 64; d.dpitch = DM; }
            }
        };
        const int lr = lane >> 3, lc = lane & 7;
        auto issue = [&](const P0Item& d, f32x4 (&t)[8], float (&wm)[4]) {
            const float* sp = d.src + (size_t)lr * d.ldw + (d.perm ? 4 * (lc & 3) + 32 * (lc >> 2) : 4 * lc);
#pragma unroll
            for (int i = 0; i < 8; ++i) t[i] = *(const f32x4*)(sp + (size_t)(8 * i) * d.ldw);
#pragma unroll
            for (int j = 0; j < 4; ++j) wm[j] = d.wmx[lr + 8 * j];
        };
        auto process = [&](const P0Item& d, const f32x4 (&t)[8], const float (&wm)[4]) {
            { LAS float* sp = scr + lr * 33 + 4 * lc;
#pragma unroll
              for (int i = 0; i < 8; ++i) { sp[(8 * i) * 33 + 0] = t[i].x; sp[(8 * i) * 33 + 1] = t[i].y; sp[(8 * i) * 33 + 2] = t[i].z; sp[(8 * i) * 33 + 3] = t[i].w; } }
            LDS_WAIT();
            const LAS float* s0 = scr + (8 * lc) * 33 + lr;
            if (set < 0) {
#pragma unroll
                for (int j = 0; j < 4; ++j) { const LAS float* s = s0 + 8 * j;
                    u32x4 o; o.x = cvtpk(s[0 * 33], s[1 * 33]); o.y = cvtpk(s[2 * 33], s[3 * 33]); o.z = cvtpk(s[4 * 33], s[5 * 33]); o.w = cvtpk(s[6 * 33], s[7 * 33]);
                    const int n = lr + 8 * j, nd = d.perm ? 2 * (n & 15) + (n >> 4) : n;
                    *(u32x4*)(d.dst + (size_t)nd * d.dpitch + 16 * lc) = o; }
            } else {
#pragma unroll
                for (int j = 0; j < 4; ++j) { const LAS float* s = s0 + 8 * j; const float inv = 127.0f / fmaxf(wm[j], 1e-30f);
                    u32x2 o; o.x = pack_i8x4((f32x4){s[0 * 33], s[1 * 33], s[2 * 33], s[3 * 33]}, inv); o.y = pack_i8x4((f32x4){s[4 * 33], s[5 * 33], s[6 * 33], s[7 * 33]}, inv);
                    *(u32x2*)(d.dst + (size_t)(lr + 8 * j) * d.dpitch + 8 * lc) = o; }
            }
            LDS_WAIT();
        };
        int il = gw; P0Item dA, dB; f32x4 tA[8], tB[8]; float wA[4], wB[4];
        decode(il, dA); issue(dA, tA, wA);
        for (;;) {
            const int ilb = il + NGW; const bool moreB = ilb < nloc;
            decode(moreB ? ilb : il, dB); issue(dB, tB, wB);
            process(dA, tA, wA);
            if (!moreB) break;
            il = ilb + NGW; const bool moreA = il < nloc;
            decode(moreA ? il : ilb, dA); issue(dA, tA, wA);
            process(dB, tB, wB);
            if (!moreA) break;
        }
    }
}

__device__ __forceinline__ void norm_phase(const void* src_lat, bool lat_bf, const void* src_ctx, bool ctx_bf, bf16* H, const float* g, const float* modl  ,
                                           int shift_idx, int scale_idx, int nrows, int tid, int G, const bf16* dlat, const bf16* part, const float* pgate, float pgs, bf16* xcopy  , bf16* xw_ctx, signed char* H8, float* rowscale) {
    asm volatile("" : "+v"(tid)); const int lane = tid & 63, wave = __builtin_amdgcn_readfirstlane(tid >> 6), gw = blockIdx.x * NWAVES + wave, NGW = G * NWAVES;
    int cur = -1; f32x4 gs[8], sh[8], pg[8];
    const bool rebal = part != nullptr && NGW == 2048 && nrows == MT;
    auto row_at = [&](int k) -> int {
        if (!rebal) { const int r = gw + k * NGW; return r < nrows ? r : -1; }
        if (gw < 1024) return k == 0 ? ML + gw : (k <= NORM_LA ? gw + 1024 * (k - 1) : -1);
        return k < 16 - NORM_LA ? 1024 * NORM_LA + (gw - 1024) + 1024 * k : -1; };
    for (int k = 0;; ++k) { const int row = row_at(k); if (row < 0) break;
        const int slot = row < ML ? (row >> 12) : 4;
        if (slot != cur) { cur = slot;
            const f32x4* g4 = (const f32x4*)g + lane; const f32x4* sc4 = (const f32x4*)(modl + (size_t)(slot * 9 + scale_idx) * DM) + lane; const f32x4* sh4 = (const f32x4*)(modl + (size_t)(slot * 9 + shift_idx) * DM) + lane;
#pragma unroll
            for (int j = 0; j < 8; ++j) { gs[j] = g4[64 * j] * (sc4[64 * j] + 1.0f); sh[j] = sh4[64 * j]; }
            if (dlat != nullptr || part != nullptr) { const f32x4* pg4 = (const f32x4*)(pgate + (size_t)slot * (9 * DM)) + lane;
#pragma unroll
                for (int j = 0; j < 8; ++j) pg[j] = pg4[64 * j] * pgs; } }
        f32x4 v[8]; float ss = 0.f;
        { const bool isl = row < ML; const void* sp = isl ? src_lat : src_ctx; const size_t ro = (size_t)(isl ? row : row - ML) * DM;
          if (isl ? lat_bf : ctx_bf) { const u32x2* xb = (const u32x2*)((const bf16*)sp + ro) + lane; u32x2 w[8];
#pragma unroll
              for (int j = 0; j < 8; ++j) w[j] = xb[64 * j];
#pragma unroll
              for (int j = 0; j < 8; ++j) v[j] = (f32x4){bflo(w[j].x), bfhi(w[j].x), bflo(w[j].y), bfhi(w[j].y)}; }
          else { const f32x4* xr = (const f32x4*)((const float*)sp + ro) + lane;
#pragma unroll
              for (int j = 0; j < 8; ++j) v[j] = xr[64 * j]; } }
        if (row < ML) { if (xcopy != nullptr) { u32x2* xw = (u32x2*)(xcopy + (size_t)row * DM) + lane;
#pragma unroll
                for (int j = 0; j < 8; ++j) { u32x2 xo; xo.x = cvtpk(v[j].x, v[j].y); xo.y = cvtpk(v[j].z, v[j].w); xw[64 * j] = xo; } } }
        else if (part != nullptr) { const u32x2* pr = (const u32x2*)(part + (size_t)(row - ML) * DM) + lane; u32x2* xw = (u32x2*)(xw_ctx + (size_t)(row - ML) * DM) + lane;
#pragma unroll
            for (int j = 0; j < 8; ++j) { u32x2 pw[8];
#pragma unroll
                for (int p = 0; p < 8; ++p) pw[p] = pr[(size_t)p * (MC * DM / 4) + 64 * j];
                f32x4 sp = (f32x4){0.f, 0.f, 0.f, 0.f};
#pragma unroll
                for (int p = 0; p < 8; ++p) sp += (f32x4){bflo(pw[p].x), bfhi(pw[p].x), bflo(pw[p].y), bfhi(pw[p].y)};
                v[j] += pg[j] * sp; u32x2 xo; xo.x = cvtpk(v[j].x, v[j].y); xo.y = cvtpk(v[j].z, v[j].w); xw[64 * j] = xo; } }
#pragma unroll
        for (int j = 0; j < 8; ++j) ss += (v[j].x * v[j].x + v[j].y * v[j].y) + (v[j].z * v[j].z + v[j].w * v[j].w);
        const float rs = 1.0f / sqrtf(wave_sum(ss) * (1.0f / DM) + EPSN);
        if (H8 != nullptr) { float am = 0.f;
#pragma unroll
            for (int j = 0; j < 8; ++j) { v[j] = v[j] * rs * gs[j] + sh[j]; am = fmaxf(fmaxf(am, fmaxf(fabsf(v[j].x), fabsf(v[j].y))), fmaxf(fabsf(v[j].z), fabsf(v[j].w))); }
            am = fmaxf(wave_max(am), 1e-30f); const float inv = 127.0f / am; unsigned* o4 = (unsigned*)(H8 + (size_t)row * DM) + lane;
#pragma unroll
            for (int j = 0; j < 8; ++j) o4[64 * j] = pack_i8x4(v[j], inv);
            if (lane == 0) rowscale[row] = am * (1.0f / 127.0f); }
        else { u32x2* o8 = (u32x2*)(H + (size_t)row * DM) + lane;
#pragma unroll
            for (int j = 0; j < 8; ++j) { const f32x4 y = v[j] * rs * gs[j] + sh[j]; u32x2 w; w.x = cvtpk(y.x, y.y); w.y = cvtpk(y.z, y.w); o8[64 * j] = w; } }
    }
}

#define SBAR() __builtin_amdgcn_sched_barrier(0)
__device__ __forceinline__ void hidden_quant_phase(const bf16* Hb, signed char* H8, float* rowscale, int nrows, int tid, int G) {
    asm volatile("" : "+v"(tid)); const int lane = tid & 63, wave = __builtin_amdgcn_readfirstlane(tid >> 6);
    const int ch = lane >> 3, sub = lane & 7;
    for (int row = blockIdx.x * NWAVES + wave; row < nrows; row += G * NWAVES) {
        u32x4 w[11]; float am = 0.f;
#pragma unroll
        for (int i = 0; i < 11; ++i) { const int c = 8 * i + ch; w[i] = (c < 86) ? *(const u32x4*)(Hb + (size_t)row * FF + c * 64 + sub * 8) : (u32x4){0u, 0u, 0u, 0u}; }
        SBAR();
#pragma unroll
        for (int i = 0; i < 11; ++i) { float x[8]; unpack8(w[i], x);
#pragma unroll
            for (int e = 0; e < 8; ++e) am = fmaxf(am, fabsf(x[e])); }
        am = fmaxf(wave_max(am) * HID_CLIP, 1e-30f); const float inv = 127.0f / am;
#pragma unroll
        for (int i = 0; i < 11; ++i) { const int c = 8 * i + ch; float x[8]; unpack8(w[i], x);
            u32x2 o; o.x = pack_i8x4((f32x4){x[0], x[1], x[2], x[3]}, inv); o.y = pack_i8x4((f32x4){x[4], x[5], x[6], x[7]}, inv);
            if (c < 88) *(u32x2*)(H8 + (size_t)row * HQP + c * 64 + sub * 8) = o; }
        if (lane == 0) rowscale[row] = am * (1.0f / 127.0f);
    }
}

__device__ __forceinline__ void row_quant_phase(const bf16* Yb, signed char* Y8, float* rowscale, int nrows, int tid, int G) {
    asm volatile("" : "+v"(tid)); const int lane = tid & 63, wave = __builtin_amdgcn_readfirstlane(tid >> 6);
    for (int row = blockIdx.x * NWAVES + wave; row < nrows; row += G * NWAVES) {
        u32x4 w[4]; float am = 0.f;
#pragma unroll
        for (int i = 0; i < 4; ++i) w[i] = *(const u32x4*)(Yb + (size_t)row * DM + (lane + 64 * i) * 8);
#pragma unroll
        for (int i = 0; i < 4; ++i) { float x[8]; unpack8(w[i], x);
#pragma unroll
            for (int e = 0; e < 8; ++e) am = fmaxf(am, fabsf(x[e])); }
        am = fmaxf(wave_max(am), 1e-30f); const float inv = 127.0f / am;
#pragma unroll
        for (int i = 0; i < 4; ++i) { float x[8]; unpack8(w[i], x); u32x2 o; o.x = pack_i8x4((f32x4){x[0], x[1], x[2], x[3]}, inv); o.y = pack_i8x4((f32x4){x[4], x[5], x[6], x[7]}, inv);
            *(u32x2*)(Y8 + (size_t)row * DM + (lane + 64 * i) * 8) = o; }
        if (lane == 0) rowscale[row] = am * (1.0f / 127.0f);
    }
}

template <int CTRL> __device__ __forceinline__ float dpp_mov(float oldv, float src) { return __int_as_float(__builtin_amdgcn_update_dpp(__float_as_int(oldv), __float_as_int(src), CTRL, 0xF, 0xF, false)); }
__device__ __forceinline__ float lane_bcast(int byte_addr, float v) { return __int_as_float(__builtin_amdgcn_ds_bpermute(byte_addr, __float_as_int(v))); }
template <bool REV> __device__ __forceinline__ void row_scan(float& a, float& b) {
#define LRU_STEP(D) do { const float ap = REV ? dpp_mov<0x100 + D>(1.0f, a) : dpp_mov<0x110 + D>(1.0f, a); const float bp = REV ? dpp_mov<0x100 + D>(0.0f, b) : dpp_mov<0x110 + D>(0.0f, b); b = fmaf(a, bp, b); a = a * ap; } while (0)
    LRU_STEP(1); LRU_STEP(2); LRU_STEP(4); LRU_STEP(8);
#undef LRU_STEP
}
struct LruConvRegs { u32x4 xv[2][4]; };
__device__ __forceinline__ void lru_unit_coords(int u, int& n, int& j, int& b, int& Lseg, int& t0, size_t& rowbase) {
    n = u & 7; j = (u >> 3) % 68; b = u / 544; const bool isctx = j < 4; Lseg = isctx ? CTXL : SEQL; t0 = isctx ? 64 * j : 64 * (j - 4); rowbase = isctx ? (size_t)(ML + CTXL * b) : (size_t)(SEQL * b);
}
__device__ __forceinline__ void lru_conv_load(LruConvRegs& R, const bf16* P, int u, int tid) {
    asm volatile("" : "+v"(tid));
    int n, j, b, Lseg, t0; size_t rowbase; lru_unit_coords(u, n, j, b, Lseg, t0, rowbase); const int c8 = (tid & 15) * 8;
#pragma unroll
    for (int pass = 0; pass < 2; ++pass)
#pragma unroll
        for (int k = 0; k < 4; ++k) { int ts = t0 + pass * 32 + (tid >> 4) + k - 2; ts = ts < 0 ? 0 : (ts > Lseg - 1 ? Lseg - 1 : ts); R.xv[pass][k] = *(const u32x4*)(P + (rowbase + ts) * ABN + 128 * n + c8); }
}
template <bool FINAL>
__device__ __forceinline__ void lru_phase(const Args& a, LAS unsigned char* lds, int tid, int lane, int wave, int G, int vc = -1, int VG = 1, int NA = 0) {
    asm volatile("" : "+v"(tid)); lane = tid & 63; wave = __builtin_amdgcn_readfirstlane(tid >> 6);
    unsigned char* ws = a.ws;
    const bf16* P = (const bf16*)(ws + WS_BIG); bf16* Y = (bf16*)(ws + WS_H); f32x2* CARRY = (f32x2*)(ws + WS_CARRY); const float* HIN = (const float*)(ws + WS_HIN); const bf16* WL = (const bf16*)(ws + WS_WLRU);
    LAS unsigned char* U = lds + LRU_U_OFF;
    LAS unsigned char* WR = lds + wave * 16384 + lane * 16;
    const int l15 = lane & 15, l4 = lane >> 4, c8 = (tid & 15) * 8;
    const int bc_last = ((lane & ~15) + 15) * 4, bc_first = (lane & ~15) * 4;
    int cur_n = -1;
    LAS f32x4* PRM = (LAS f32x4*)(lds + LRU_U_OFF + 17408) + wave * 24 + l4;
    LruConvRegs CR;
    constexpr int NU = 4 * 68 * 8;
    const int kA = (vc >= 0 && vc < NA) ? (NA - vc + VG - 1) / VG : 0;
    auto unit_at = [&](int k) -> int { return k < kA ? vc + k * VG : NA + (int)blockIdx.x + (k - kA) * G; };
    if (unit_at(0) < NU) lru_conv_load(CR, P, unit_at(0), tid);
    for (int k = 0;; ++k) { const int u = unit_at(k); if (u >= NU) break;
        int n, j, b, Lseg, t0; size_t rowbase; lru_unit_coords(u, n, j, b, Lseg, t0, rowbase);
        if (n != cur_n) { cur_n = n; int l15x = l15; asm volatile("" : "+v"(l15x));
#pragma unroll
            for (int dir = 0; dir < 2; ++dir)
#pragma unroll
                for (int gt = 0; gt < 2; ++gt)
#pragma unroll
                    for (int ks = 0; ks < 4; ++ks) *(LAS bf16x8*)(WR + ((dir * 2 + gt) * 4 + ks) * 1024) = *(const bf16x8*)(WL + ((size_t)(((dir * 2 + gt) * 8 + n) * 128 + 16 * wave + l15x)) * 128 + 32 * ks + 8 * l4);
            int l4x = l4; asm volatile("" : "+v"(l4x));
#pragma unroll
            for (int dir = 0; dir < 2; ++dir) { const int ch = dir * 1024 + 128 * n + 16 * wave + 4 * l4x; const f32x4 bav = *(const f32x4*)(a.in[IN_LBA] + ch), bxv = *(const f32x4*)(a.in[IN_LBX] + ch), lmv = *(const f32x4*)(a.in[IN_LAM] + ch);
                f32x4 spv;
#pragma unroll
                for (int jj = 0; jj < 4; ++jj) { const float lm = -lmv[jj]; spv[jj] = (fmaxf(lm, 0.f) + log1pf(expf(-fabsf(lm)))) * (-8.0f * 1.4426950408889634f); }
                PRM[(dir * 3 + 0) * 4] = bav; PRM[(dir * 3 + 1) * 4] = bxv; PRM[(dir * 3 + 2) * 4] = spv; }
        }
        { float y[2][8]; const float* cwp = a.in[IN_CONVW] + 128 * n + c8; const float* cbp = a.in[IN_CONVB] + 128 * n + c8;
          f32x4 w0[4], w1[4]; const f32x4 b0 = *(const f32x4*)cbp, b1 = *(const f32x4*)(cbp + 4);
#pragma unroll
          for (int k = 0; k < 4; ++k) { w0[k] = *(const f32x4*)(cwp + k * 1024); w1[k] = *(const f32x4*)(cwp + k * 1024 + 4); }
          SBAR();
#pragma unroll
          for (int pass = 0; pass < 2; ++pass) {
#pragma unroll
            for (int e = 0; e < 4; ++e) { y[pass][e] = b0[e]; y[pass][4 + e] = b1[e]; }
#pragma unroll
            for (int k = 0; k < 4; ++k) { const int ts = t0 + pass * 32 + (tid >> 4) + k - 2; const float msk = (ts >= 0 && ts < Lseg) ? 1.0f : 0.0f; float x[8]; unpack8(CR.xv[pass][k], x);
#pragma unroll
                for (int e = 0; e < 4; ++e) { y[pass][e] = fmaf(x[e] * msk, w0[k][e], y[pass][e]); y[pass][4 + e] = fmaf(x[4 + e] * msk, w1[k][e], y[pass][4 + e]); } }
            *(LAS u32x4*)(U + (pass * 32 + (tid >> 4)) * 272 + c8 * 2) = pack8(y[pass]); } }
        LDS_BARRIER();
        { const int un = unit_at(k + 1); if (un < NU) lru_conv_load(CR, P, un, tid); }
        f32x4 hin[2];
        if (FINAL) {
#pragma unroll
            for (int dir = 0; dir < 2; ++dir) hin[dir] = *(const f32x4*)(HIN + (size_t)(((b * 2 + dir) * 68 + j)) * 1024 + 128 * n + 16 * wave + 4 * l4);
        }
        f32x4 hsum[4];
#pragma unroll
        for (int dir = 0; dir < 2; ++dir) {
            f32x4 acc[2][4]; bf16x8 wf[2][4];
#pragma unroll
            for (int gt = 0; gt < 2; ++gt)
#pragma unroll
                for (int ks = 0; ks < 4; ++ks) wf[gt][ks] = *(const LAS bf16x8*)(WR + ((dir * 2 + gt) * 4 + ks) * 1024);
#pragma unroll
            for (int mt = 0; mt < 4; ++mt) { bf16x8 uf[4];
#pragma unroll
                for (int ks = 0; ks < 4; ++ks) uf[ks] = *(const LAS bf16x8*)(U + (16 * mt + l15) * 272 + (32 * ks + 8 * l4) * 2);
#pragma unroll
                for (int gt = 0; gt < 2; ++gt) { f32x4 c4 = (f32x4){0.f, 0.f, 0.f, 0.f};
#pragma unroll
                    for (int ks = 0; ks < 4; ++ks) c4 = __builtin_amdgcn_mfma_f32_16x16x32_bf16(wf[gt][ks], uf[ks], c4, 0, 0, 0);
                    acc[gt][mt] = c4; } }
            f32x4 av[4], bv[4]; const f32x4 ba = PRM[(dir * 3 + 0) * 4], bx = PRM[(dir * 3 + 1) * 4], sp = PRM[(dir * 3 + 2) * 4];
#pragma unroll
            for (int mt = 0; mt < 4; ++mt) { const u32x2 uw = *(const LAS u32x2*)(U + (16 * mt + l15) * 272 + (16 * wave + 4 * l4) * 2);
                const float uu[4] = {bflo(uw.x), bfhi(uw.x), bflo(uw.y), bfhi(uw.y)};
#pragma unroll
                for (int jj = 0; jj < 4; ++jj) { const float r = sigmoid_f(acc[0][mt][jj] + ba[jj]), ig = sigmoid_f(acc[1][mt][jj] + bx[jj]);
                    const float aa = __builtin_amdgcn_exp2f(r * sp[jj]);
                    av[mt][jj] = aa; bv[mt][jj] = sqrtf(fmaxf(1.0f - aa * aa, 0.f)) * (ig * uu[jj]); } }
#pragma unroll
            for (int jj = 0; jj < 4; ++jj) { float cA = 1.0f, cH = FINAL ? hin[dir][jj] : 0.0f;
#pragma unroll
                for (int q = 0; q < 4; ++q) { const int mt = dir == 0 ? q : 3 - q; float aa = av[mt][jj], hh = bv[mt][jj];
                    if (dir == 0) row_scan<false>(aa, hh); else row_scan<true>(aa, hh);
                    hh = fmaf(aa, cH, hh);
                    if (q < 3 || !FINAL) { if (!FINAL) cA = lane_bcast(dir == 0 ? bc_last : bc_first, aa * cA); cH = lane_bcast(dir == 0 ? bc_last : bc_first, hh); }
                    if (FINAL) { if (dir == 0) hsum[mt][jj] = hh; else hsum[mt][jj] += hh; } }
                if (!FINAL) { av[0][jj] = cA; bv[0][jj] = cH; } }
            if (!FINAL) { if (l15 == 0) { f32x2* cr = CARRY + (size_t)((b * 2 + dir) * 68 + j) * 1024 + 128 * n + 16 * wave + 4 * l4;
#pragma unroll
                for (int jj = 0; jj < 4; ++jj) cr[jj] = (f32x2){av[0][jj], bv[0][jj]}; } }
        }
        if (FINAL) {
            u32x2 glw[4];
#pragma unroll
            for (int mt = 0; mt < 4; ++mt) glw[mt] = *(const u32x2*)(P + (rowbase + t0 + 16 * mt + l15) * ABN + 1024 + 128 * n + 16 * wave + 4 * l4);
            SBAR();
#pragma unroll
            for (int mt = 0; mt < 4; ++mt) { const float gl[4] = {bflo(glw[mt].x), bfhi(glw[mt].x), bflo(glw[mt].y), bfhi(glw[mt].y)}; float o[4];
#pragma unroll
                for (int jj = 0; jj < 4; ++jj) { const float x = gl[jj]; const float z2 = 1.5957691216057308f * (x + 0.044715f * x * x * x); o[jj] = hsum[mt][jj] * (x * sigmoid_f(z2)); }
                u32x2 w; w.x = cvtpk(o[0], o[1]); w.y = cvtpk(o[2], o[3]);
                *(u32x2*)(Y + (rowbase + t0 + 16 * mt + l15) * DM + 128 * n + 16 * wave + 4 * l4) = w; }
        }
        LDS_BARRIER();
    }
    __syncthreads();
}
__device__ __forceinline__ void lru_carry_scan(const Args& a, int tid, int G) {
    asm volatile("" : "+v"(tid));
    const f32x2* CARRY = (const f32x2*)(a.ws + WS_CARRY); float* HIN = (float*)(a.ws + WS_HIN);
    for (int id = blockIdx.x * (NWAVES * 64) + tid; id < 4 * 2 * 1024; id += G * (NWAVES * 64)) {
        const int c = id & 1023, dir = (id >> 10) & 1, b = id >> 11; const f32x2* cr = CARRY + (size_t)((b * 2 + dir) * 68) * 1024 + c; float* hp = HIN + (size_t)((b * 2 + dir) * 68) * 1024 + c; float h = 0.f;
        for (int q0 = 0; q0 < 68; q0 += 17) { f32x2 ce[17];
#pragma unroll
            for (int i = 0; i < 17; ++i) { const int q = q0 + i; const int jx = dir == 0 ? q : (q < 4 ? 3 - q : 71 - q); ce[i] = cr[(size_t)jx * 1024]; }
            SBAR();
#pragma unroll
            for (int i = 0; i < 17; ++i) { const int q = q0 + i; const int jx = dir == 0 ? q : (q < 4 ? 3 - q : 71 - q); hp[(size_t)jx * 1024] = h; h = fmaf(ce[i].x, h, ce[i].y); } }
    }
}

#define KSWZ(row, colB) ((row) * 256 + ((colB) ^ (((row) & 7) << 4)))
constexpr int AT_V = 0, AT_K = 16384, AT_BUF = 32768, AT_WS = 65536, AT_RPB = 67584, AT_ROPE = 67584, AT_OST = 83968;
constexpr float AT_THR = 8.f;
__device__ __forceinline__ int crow(int r, int hi) { return (r & 3) + 8 * (r >> 2) + 4 * hi; }
__device__ __forceinline__ void partialSM(f32x16& p0, f32x16& p1, float& m_reg, float& mn, float& alpha) {
    constexpr float C = ATT_SCALE * 1.4426950408889634f;
    float pmax = p0[0];
#pragma unroll
    for (int r = 1; r < 16; ++r) pmax = fmaxf(pmax, p0[r]);
#pragma unroll
    for (int r = 0; r < 16; ++r) pmax = fmaxf(pmax, p1[r]);
    { auto rr = __builtin_amdgcn_permlane32_swap(__float_as_uint(pmax), __float_as_uint(pmax), false, false); pmax = fmaxf(__uint_as_float(rr[0]), __uint_as_float(rr[1])); }
    if (__builtin_expect(__all(pmax - m_reg <= AT_THR / ATT_SCALE), 1)) { mn = m_reg; alpha = 1.f; }
    else { mn = fmaxf(m_reg, pmax); alpha = __builtin_amdgcn_exp2f((m_reg - mn) * C); m_reg = mn; }
    const float mnC = -mn * C;
#pragma unroll
    for (int r = 0; r < 16; ++r) p0[r] = __builtin_amdgcn_exp2f(fmaf(p0[r], C, mnC));
#pragma unroll
    for (int r = 0; r < 16; ++r) p1[r] = __builtin_amdgcn_exp2f(fmaf(p1[r], C, mnC));
}
__device__ __forceinline__ void finishSM(const f32x16& p0, const f32x16& p1, float alpha, float& l_reg, bf16x8& pa0, bf16x8& pa1, bf16x8& pa2, bf16x8& pa3) {
    float ps = 0.f;
#pragma unroll
    for (int r = 0; r < 16; ++r) ps += p0[r];
#pragma unroll
    for (int r = 0; r < 16; ++r) ps += p1[r];
    { auto rr = __builtin_amdgcn_permlane32_swap(__float_as_uint(ps), __float_as_uint(ps), false, false); ps = __uint_as_float(rr[0]) + __uint_as_float(rr[1]); }
    l_reg = l_reg * alpha + ps;
#define PK4(P, BASE, OUT) do { unsigned a0 = cvtpk(P[BASE + 0], P[BASE + 1]), a1 = cvtpk(P[BASE + 2], P[BASE + 3]);   \
    unsigned b0 = cvtpk(P[BASE + 4], P[BASE + 5]), b1 = cvtpk(P[BASE + 6], P[BASE + 7]);                              \
    auto r0 = __builtin_amdgcn_permlane32_swap(a0, b0, false, false); auto r1 = __builtin_amdgcn_permlane32_swap(a1, b1, false, false); \
    u32x4 w = {r0[0], r1[0], r0[1], r1[1]}; OUT = __builtin_bit_cast(bf16x8, w); } while (0)
    PK4(p0, 0, pa0); PK4(p0, 8, pa1); PK4(p1, 0, pa2); PK4(p1, 8, pa3);
#undef PK4
}
__device__ __forceinline__ void qkt(f32x16& p0, f32x16& p1, const LAS unsigned char* Ks, const bf16x8* qr, int r32, int hi) {
#pragma unroll
    for (int r = 0; r < 16; ++r) { p0[r] = 0.f; p1[r] = 0.f; }
#pragma unroll
    for (int d0 = 0; d0 < 8; ++d0) { const int cb = (d0 * 16 + hi * 8) * 2;
        const bf16x8 b0 = *(const LAS bf16x8*)(Ks + KSWZ(r32, cb)); const bf16x8 b1 = *(const LAS bf16x8*)(Ks + KSWZ(32 + r32, cb));
        p0 = __builtin_amdgcn_mfma_f32_32x32x16_bf16(b0, qr[d0], p0, 0, 0, 0); p1 = __builtin_amdgcn_mfma_f32_32x32x16_bf16(b1, qr[d0], p1, 0, 0, 0); }
}
__device__ __forceinline__ int v_st(int k, int c) { const int kk = (k & ~0xC) | ((k & 4) << 1) | ((k & 8) >> 1); return ((kk >> 3) * 4 + (c >> 5)) * 512 + ((kk & 7) * 32 + (c & 31)) * 2; }
__device__ __forceinline__ int v_rd_base(int lane) { return ((lane & 3) << 3) | (((lane >> 2) & 3) << 6) | (((lane >> 4) & 1) << 5) | (((lane >> 5) & 1) << 8); }
constexpr int v_rd_off(int d0, int ks, int half) { return d0 * 512 + ks * 4096 + half * 2048; }
template <int OFF> __device__ __forceinline__ s16x4 tr_read(int vb) { s16x4 r; asm volatile("ds_read_b64_tr_b16 %0, %1 offset:%2" : "=&v"(r) : "v"(vb), "i"(OFF) : "memory"); return r; }
template <int D0> __device__ __forceinline__ void pv_one(f32x16& od, int vb, bf16x8 pa0, bf16x8 pa1, bf16x8 pa2, bf16x8 pa3) {
    const s16x4 l0 = tr_read<v_rd_off(D0, 0, 0)>(vb), h0 = tr_read<v_rd_off(D0, 0, 1)>(vb), l1 = tr_read<v_rd_off(D0, 1, 0)>(vb), h1 = tr_read<v_rd_off(D0, 1, 1)>(vb);
    const s16x4 l2 = tr_read<v_rd_off(D0, 2, 0)>(vb), h2 = tr_read<v_rd_off(D0, 2, 1)>(vb), l3 = tr_read<v_rd_off(D0, 3, 0)>(vb), h3 = tr_read<v_rd_off(D0, 3, 1)>(vb);
    asm volatile("s_waitcnt lgkmcnt(0)" ::: "memory"); SBAR();
#define PKV(L, H) (bf16x8){L[0], L[1], L[2], L[3], H[0], H[1], H[2], H[3]}
    od = __builtin_amdgcn_mfma_f32_32x32x16_bf16(pa0, PKV(l0, h0), od, 0, 0, 0);
    od = __builtin_amdgcn_mfma_f32_32x32x16_bf16(pa1, PKV(l1, h1), od, 0, 0, 0);
    od = __builtin_amdgcn_mfma_f32_32x32x16_bf16(pa2, PKV(l2, h2), od, 0, 0, 0);
    od = __builtin_amdgcn_mfma_f32_32x32x16_bf16(pa3, PKV(l3, h3), od, 0, 0, 0);
#undef PKV
}
__device__ __forceinline__ void sm_pv(f32x16& p0, f32x16& p1, f32x16 (&o)[4], float& m_reg, float& l_reg, int vb, LAS float* al_l, int r32, int hi) {
    float mn, alpha; partialSM(p0, p1, m_reg, mn, alpha);
    if (__any(alpha < 1.f)) { if (hi == 0) al_l[r32] = alpha; LDS_WAIT();
#pragma unroll
        for (int d = 0; d < 4; ++d)
#pragma unroll
            for (int r = 0; r < 16; ++r) o[d][r] *= al_l[crow(r, hi)];
        LDS_WAIT(); }
    bf16x8 pa0, pa1, pa2, pa3; finishSM(p0, p1, alpha, l_reg, pa0, pa1, pa2, pa3); SBAR();
    pv_one<0>(o[0], vb, pa0, pa1, pa2, pa3); pv_one<1>(o[1], vb, pa0, pa1, pa2, pa3); pv_one<2>(o[2], vb, pa0, pa1, pa2, pa3); pv_one<3>(o[3], vb, pa0, pa1, pa2, pa3);
}
__device__ __forceinline__ void tile_prefetch(u32x4 (&kw)[2], u32x4 (&vw)[2], const bf16* Kb, const bf16* Vb, int ld, int tid) {
    const int sr = tid >> 4, sc = (tid & 15) * 8;
#pragma unroll
    for (int hh = 0; hh < 2; ++hh) { const int rr = sr + 32 * hh; kw[hh] = *(const u32x4*)(Kb + (size_t)rr * ld + sc); vw[hh] = *(const u32x4*)(Vb + (size_t)rr * ld + sc); }
}
__device__ __forceinline__ void tile_commit(const u32x4 (&kw)[2], const u32x4 (&vw)[2], const float* kg, bool rope, int ktok0, const LAS f32x2* ROPE, LAS unsigned char* lds, int boff, int tid) {
    asm volatile("" : "+v"(tid));
    const int sr = tid >> 4, sc = (tid & 15) * 8, l16 = tid & 15;
    float kgv[8]; { const f32x4 g0 = *(const f32x4*)(kg + sc), g1 = *(const f32x4*)(kg + sc + 4); kgv[0] = g0[0]; kgv[1] = g0[1]; kgv[2] = g0[2]; kgv[3] = g0[3]; kgv[4] = g1[0]; kgv[5] = g1[1]; kgv[6] = g1[2]; kgv[7] = g1[3]; }
#pragma unroll
    for (int hh = 0; hh < 2; ++hh) { const int rr = sr + 32 * hh; float y[8]; unpack8(kw[hh], y); float ss = 0.f;
#pragma unroll
        for (int e = 0; e < 8; ++e) ss += y[e] * y[e];
        ss += swz_xor<1>(ss); ss += swz_xor<2>(ss); ss += swz_xor<4>(ss); ss += swz_xor<8>(ss);
        const float rs = 1.0f / sqrtf(ss * (1.0f / 128.0f) + EPSN);
#pragma unroll
        for (int e = 0; e < 8; ++e) y[e] *= rs * kgv[e];
        if (rope) { const int tok = ktok0 + rr; const int pos = (l16 < 8) ? (tok >> 6) : (tok & 63); const LAS f32x2* rp = ROPE + pos * 32 + (l16 & 3) * 8; const float sg = (l16 & 4) ? 1.f : -1.f;
#pragma unroll
            for (int e = 0; e < 8; ++e) { const float pr = swz_xor<4>(y[e]); const f32x2 cs = rp[e]; y[e] = y[e] * cs.x + sg * pr * cs.y; } }
        *(LAS u32x4*)(lds + boff + AT_K + KSWZ(rr, sc * 2)) = pack8(y);
        *(LAS u32x4*)(lds + boff + AT_V + v_st(rr, sc)) = vw[hh]; }
}
__device__ __forceinline__ void tile_commit_plain(const u32x4 (&kw)[2], const u32x4 (&vw)[2], LAS unsigned char* lds, int boff, int tid) {
    asm volatile("" : "+v"(tid));
    const int sr = tid >> 4, sc = (tid & 15) * 8;
#pragma unroll
    for (int hh = 0; hh < 2; ++hh) { const int rr = sr + 32 * hh; *(LAS u32x4*)(lds + boff + AT_K + KSWZ(rr, sc * 2)) = kw[hh]; *(LAS u32x4*)(lds + boff + AT_V + v_st(rr, sc)) = vw[hh]; }
}
__device__ __forceinline__ void load_q_plain(bf16x8 (&qr)[8], const bf16* qp, int hi) {
#pragma unroll
    for (int d0 = 0; d0 < 8; ++d0) qr[d0] = __builtin_bit_cast(bf16x8, *(const u32x4*)(qp + d0 * 16 + hi * 8));
}
__device__ __forceinline__ void load_q(bf16x8 (&qr)[8], const bf16* qp  , const float* qg, bool rope, int qtok, const LAS f32x2* ROPE, int hi) {
    u32x4 w[8]; f32x4 g[16];
#pragma unroll
    for (int d0 = 0; d0 < 8; ++d0) w[d0] = *(const u32x4*)(qp + d0 * 16 + hi * 8);
#pragma unroll
    for (int d0 = 0; d0 < 8; ++d0) { g[2 * d0] = *(const f32x4*)(qg + d0 * 16 + hi * 8); g[2 * d0 + 1] = *(const f32x4*)(qg + d0 * 16 + hi * 8 + 4); }
    SBAR();
    float x[8][8]; float ss = 0.f;
#pragma unroll
    for (int d0 = 0; d0 < 8; ++d0) { unpack8(w[d0], x[d0]);
#pragma unroll
        for (int e = 0; e < 8; ++e) ss += x[d0][e] * x[d0][e]; }
    ss = half_sum(ss);
    const float rs = 1.0f / sqrtf(ss * (1.0f / 128.0f) + EPSN);
#pragma unroll
    for (int d0 = 0; d0 < 8; ++d0)
#pragma unroll
        for (int e = 0; e < 4; ++e) { x[d0][e] *= rs * g[2 * d0][e]; x[d0][4 + e] *= rs * g[2 * d0 + 1][e]; }
    if (rope) {
#pragma unroll
        for (int half = 0; half < 2; ++half) { const int pos = half ? (qtok & 63) : (qtok >> 6);
#pragma unroll
            for (int dd = 0; dd < 2; ++dd) { const int d0 = half * 4 + dd; const LAS f32x2* rp = ROPE + pos * 32 + dd * 16 + hi * 8;
#pragma unroll
                for (int e = 0; e < 8; ++e) { const f32x2 cs = rp[e]; const float x1 = x[d0][e], x2 = x[d0 + 2][e]; x[d0][e] = x1 * cs.x - x2 * cs.y; x[d0 + 2][e] = x2 * cs.x + x1 * cs.y; } } } }
#pragma unroll
    for (int d0 = 0; d0 < 8; ++d0) qr[d0] = __builtin_bit_cast(bf16x8, pack8(x[d0]));
}
__device__ __forceinline__ void store_o(const f32x16 (&o)[4], float l_reg, bf16* yb, LAS float* li_l, LAS unsigned char* ost, int lane, int hstep = 16) {
    int r32 = lane & 31, hi = lane >> 5;
    if (hi == 0) li_l[r32] = l_reg; LDS_WAIT();
    asm volatile("" : "+v"(hi));
    int l2 = lane; asm volatile("" : "+v"(l2));
#pragma unroll
    for (int p = 0; p < 2; ++p) {
#pragma unroll
        for (int r = 8 * p; r < 8 * p + 8; ++r) { const int orow = crow(r, hi); const float rl = __builtin_amdgcn_rcpf(li_l[orow]);
#pragma unroll
            for (int d0 = 0; d0 < 4; ++d0) *(LAS unsigned short*)(ost + (orow & 15) * 256 + (d0 * 32 + r32) * 2) = f2bf(o[d0][r] * rl); }
        LDS_WAIT();
#pragma unroll
        for (int i = 0; i < 4; ++i) { const int orow = 4 * i + (l2 >> 4), ch = l2 & 15; const u32x4 w = *(const LAS u32x4*)(ost + orow * 256 + ch * 16);
            *(u32x4*)(yb + (size_t)(p * hstep + orow) * DM + ch * 8) = w; }
        LDS_WAIT(); }
}

__device__ __forceinline__ void attn_ab_phase(const Args& a, LAS unsigned char* lds, int tid, int lane, int wave, int G) {
    asm volatile("" : "+v"(tid)); lane = tid & 63; wave = __builtin_amdgcn_readfirstlane(tid >> 6);
    unsigned char* ws = a.ws;
    const bf16* P = (const bf16*)(ws + WS_BIG); bf16* Y = (bf16*)(ws + WS_H);
    const int r32 = lane & 31, hi = lane >> 5;
    const int vb = (int)(uintptr_t)(lds + AT_V) + v_rd_base(lane);
    LAS float* wsf = (LAS float*)(lds + AT_WS) + wave * 64;
    for (int u = blockIdx.x; u < 544; u += G) {
        const bool lat = u < 512; const int v = u - 512;
        const int b = lat ? (u >> 7) : (v >> 3), kvh = lat ? ((u >> 6) & 1) : ((v >> 2) & 1), qb = lat ? (u & 63) : (v & 3);
        const int h = 4 * kvh + (wave >> 1), qi = 32 * (wave & 1) + r32, qtok = 64 * qb + qi;
        const size_t qrow = lat ? (size_t)(SEQL * b + qtok) : (size_t)(ML + CTXL * b + qtok);
        bf16x8 qr[8]; load_q_plain(qr, P + qrow * ABN + 2048 + h * 128, hi);
        float m_reg = a.in[IN_SINK][h] * (1.0f / ATT_SCALE), l_reg = 1.f;
        f32x16 o[4];
#pragma unroll
        for (int d = 0; d < 4; ++d)
#pragma unroll
            for (int r = 0; r < 16; ++r) o[d][r] = 0.f;
        const int kt_lo = lat ? (qb < 2 ? 2 - qb : 0) : 0, kt_hi = lat ? (qb > 61 ? 65 - qb : 4) : -1, nloc = kt_hi - kt_lo + 1, nt = nloc + 4;
        const bf16* Pk = P + 3072 + 128 * kvh; const size_t lrow0 = (size_t)(SEQL * b + 64 * qb - 128), crow0 = (size_t)(ML + CTXL * b);
        u32x4 kw[2], vw[2];
        __syncthreads();
        { const size_t kr0 = nloc > 0 ? lrow0 + 64 * kt_lo : crow0; tile_prefetch(kw, vw, Pk + kr0 * ABN, Pk + kr0 * ABN + 256, ABN, tid);
          tile_commit_plain(kw, vw, lds, 0, tid); }
        for (int ti = 0; ti < nt; ++ti) {
            const bool loc = ti < nloc; const int kt = kt_lo + ti; const int boff = (ti & 1) * AT_BUF;
            if (ti + 1 < nt) { const size_t kr1 = (ti + 1 < nloc) ? lrow0 + 64 * (kt + 1) : crow0 + 64 * (ti + 1 - nloc); tile_prefetch(kw, vw, Pk + kr1 * ABN, Pk + kr1 * ABN + 256, ABN, tid); }
            LDS_BARRIER();
            f32x16 p0, p1; qkt(p0, p1, lds + boff + AT_K, qr, r32, hi);
            int qim = qi; asm volatile("" : "+v"(qim));
            if (loc && kt == 0) {
#pragma unroll
                for (int r = 0; r < 16; ++r) { const int kk = crow(r, hi); p0[r] = (kk >= qim) ? p0[r] : -INFINITY; p1[r] = (kk + 32 >= qim) ? p1[r] : -INFINITY; } }
            if (loc && kt == 4) {
#pragma unroll
                for (int r = 0; r < 16; ++r) { const int kk = crow(r, hi); p0[r] = (kk <= qim) ? p0[r] : -INFINITY; p1[r] = (kk + 32 <= qim) ? p1[r] : -INFINITY; } }
            sm_pv(p0, p1, o, m_reg, l_reg, vb + boff, wsf + 32, r32, hi);
            if (ti + 1 < nt) tile_commit_plain(kw, vw, lds, AT_BUF - boff, tid);
        }
        const size_t orow0 = qrow - r32;
        store_o(o, l_reg, Y + orow0 * DM + 1024 + h * 128, wsf, lds + AT_OST + wave * 4096, lane);
    }
    __syncthreads();
}

__device__ __forceinline__ void qkt32(f32x16& p0, const LAS unsigned char* Ks  , const bf16x8* qr, const int (&ka)[8]) {
#pragma unroll
    for (int r = 0; r < 16; ++r) p0[r] = 0.f;
#pragma unroll
    for (int d0 = 0; d0 < 8; ++d0) { const bf16x8 b0 = *(const LAS bf16x8*)(Ks + ka[d0]); p0 = __builtin_amdgcn_mfma_f32_32x32x16_bf16(b0, qr[d0], p0, 0, 0, 0); }
}
__device__ __forceinline__ void qkt_ka(f32x16& p0, f32x16& p1, const LAS unsigned char* Ks, const bf16x8* qr, const int (&ka)[8]) {
#pragma unroll
    for (int r = 0; r < 16; ++r) { p0[r] = 0.f; p1[r] = 0.f; }
#pragma unroll
    for (int d0 = 0; d0 < 8; ++d0) { const bf16x8 b0 = *(const LAS bf16x8*)(Ks + ka[d0]); const bf16x8 b1 = *(const LAS bf16x8*)(Ks + ka[d0] + 32 * 256);
        p0 = __builtin_amdgcn_mfma_f32_32x32x16_bf16(b0, qr[d0], p0, 0, 0, 0); p1 = __builtin_amdgcn_mfma_f32_32x32x16_bf16(b1, qr[d0], p1, 0, 0, 0); }
}
__device__ __forceinline__ int v_rd_base_span(int lane, int cs) {
    const int common = ((lane & 3) << 3) | (((lane >> 2) & 3) << 6) | (((lane >> 4) & 1) << 5), L = (lane >> 5) & 1;
    return common + (cs >> 4) * 4096 + ((cs & 8) ? (L ? 4096 : 256) : (L ? 256 : 0));
}
template <int D0> __device__ __forceinline__ void pv_one32(f32x16& od, int vb, bf16x8 pa0, bf16x8 pa1) {
    const s16x4 l0 = tr_read<v_rd_off(D0, 0, 0)>(vb), h0 = tr_read<v_rd_off(D0, 0, 1)>(vb), l1 = tr_read<v_rd_off(D0, 1, 0)>(vb), h1 = tr_read<v_rd_off(D0, 1, 1)>(vb);
    asm volatile("s_waitcnt lgkmcnt(0)" ::: "memory"); SBAR();
#define PKV(L, H) (bf16x8){L[0], L[1], L[2], L[3], H[0], H[1], H[2], H[3]}
    od = __builtin_amdgcn_mfma_f32_32x32x16_bf16(pa0, PKV(l0, h0), od, 0, 0, 0);
    od = __builtin_amdgcn_mfma_f32_32x32x16_bf16(pa1, PKV(l1, h1), od, 0, 0, 0);
#undef PKV
}
__device__ __forceinline__ void sm_pv32(f32x16& p0, f32x16 (&o)[4], float& m_reg, float& l_reg, int vbs, LAS float* al_l, int r32, int hi) {
    constexpr float C = ATT_SCALE * 1.4426950408889634f;
    float pmax = p0[0];
#pragma unroll
    for (int r = 1; r < 16; ++r) pmax = fmaxf(pmax, p0[r]);
    { auto rr = __builtin_amdgcn_permlane32_swap(__float_as_uint(pmax), __float_as_uint(pmax), false, false); pmax = fmaxf(__uint_as_float(rr[0]), __uint_as_float(rr[1])); }
    float mn, alpha;
    if (__builtin_expect(__all(pmax - m_reg <= AT_THR / ATT_SCALE), 1)) { mn = m_reg; alpha = 1.f; }
    else { mn = fmaxf(m_reg, pmax); alpha = __builtin_amdgcn_exp2f((m_reg - mn) * C); m_reg = mn; }
    const float mnC = -mn * C; float ps = 0.f;
#pragma unroll
    for (int r = 0; r < 16; ++r) { p0[r] = __builtin_amdgcn_exp2f(fmaf(p0[r], C, mnC)); ps += p0[r]; }
    if (__any(alpha < 1.f)) { if (hi == 0) al_l[r32] = alpha; LDS_WAIT();
#pragma unroll
        for (int d = 0; d < 4; ++d)
#pragma unroll
            for (int r = 0; r < 16; ++r) o[d][r] *= al_l[crow(r, hi)];
        LDS_WAIT(); }
    { auto rr = __builtin_amdgcn_permlane32_swap(__float_as_uint(ps), __float_as_uint(ps), false, false); ps = __uint_as_float(rr[0]) + __uint_as_float(rr[1]); }
    l_reg = l_reg * alpha + ps;
    bf16x8 pa0, pa1;
#define PK4(P, BASE, OUT) do { unsigned a0 = cvtpk(P[BASE + 0], P[BASE + 1]), a1 = cvtpk(P[BASE + 2], P[BASE + 3]);   \
    unsigned b0 = cvtpk(P[BASE + 4], P[BASE + 5]), b1 = cvtpk(P[BASE + 6], P[BASE + 7]);                              \
    auto r0 = __builtin_amdgcn_permlane32_swap(a0, b0, false, false); auto r1 = __builtin_amdgcn_permlane32_swap(a1, b1, false, false); \
    u32x4 w = {r0[0], r1[0], r0[1], r1[1]}; OUT = __builtin_bit_cast(bf16x8, w); } while (0)
    PK4(p0, 0, pa0); PK4(p0, 8, pa1);
#undef PK4
    SBAR();
    pv_one32<0>(o[0], vbs, pa0, pa1); pv_one32<1>(o[1], vbs, pa0, pa1); pv_one32<2>(o[2], vbs, pa0, pa1); pv_one32<3>(o[3], vbs, pa0, pa1);
}

__device__ __forceinline__ void attn_na_phase(const Args& a, LAS unsigned char* lds, int tid, int lane, int wave, int G) {
    asm volatile("" : "+v"(tid)); lane = tid & 63; wave = __builtin_amdgcn_readfirstlane(tid >> 6);
    unsigned char* ws = a.ws;
    const bf16* Q = (const bf16*)(ws + WS_BIG); bf16* Y = (bf16*)(ws + WS_H);
    const int r32 = lane & 31, hi = lane >> 5;
    const int m = wave & 3, pr = wave >> 2, cs = m == 0 ? 0 : (m == 1 ? 8 : (m == 2 ? 24 : 32));
    const int vb = (int)(uintptr_t)(lds + AT_V) + v_rd_base(lane), vbs = (int)(uintptr_t)(lds + AT_V) + v_rd_base_span(lane, cs);
    LAS float* wsf = (LAS float*)(lds + AT_WS) + wave * 64;
    LAS float* RPB = (LAS float*)(lds + AT_RPB);
    int ka[8];
#pragma unroll
    for (int d0 = 0; d0 < 8; ++d0) ka[d0] = KSWZ(r32, (d0 * 16 + hi * 8) * 2);
    for (int u = blockIdx.x; u < 1024; u += G) {
        const int b = u >> 8, h = (u >> 4) & 15, R = u & 15;
        const int ra = 4 * R + 2 * pr, r = ra + (r32 >> 4), qc = 16 * m + (r32 & 15), qtok = 64 * r + qc;
        const size_t qrow = (size_t)(SEQL * b + qtok);
        bf16x8 qr[8]; load_q_plain(qr, Q + qrow * NAN3 + h * 128, hi);
        __syncthreads();
        if (tid < 465) RPB[(tid / 31) * 128 + 48 + (tid % 31)] = a.in[IN_RPB][h * 465 + tid] * (1.0f / ATT_SCALE);
        float m_reg = -1e30f, l_reg = 0.f;
        f32x16 o[4];
#pragma unroll
        for (int d = 0; d < 4; ++d)
#pragma unroll
            for (int rr = 0; rr < 16; ++rr) o[d][rr] = 0.f;
        const int c0 = 4 * R - 4, c1 = 4 * R - 1;
        const int kr_lo = c0 < 0 ? 0 : (c0 > 56 ? 56 : c0), kr_hi = (c1 < 0 ? 0 : (c1 > 56 ? 56 : c1)) + 7;
        const int rsa = (ra - 4) < 0 ? 0 : ((ra - 4) > 56 ? 56 : (ra - 4)), rsb = (ra - 3) < 0 ? 0 : ((ra - 3) > 56 ? 56 : (ra - 3));
        const int rsl = (r32 >> 4) ? rsb : rsa;
        const int wsq = (qc - 8) < 0 ? 0 : ((qc - 8) > 48 ? 48 : (qc - 8));
        const int nloc = kr_hi - kr_lo + 1, nt = nloc + 4;
        const bf16* Qk = Q + 2048 + h * 128; const size_t lrow0 = (size_t)(SEQL * b), crow0 = (size_t)(ML + CTXL * b);
        u32x4 kw[2], vw[2];
        { const size_t kr0 = lrow0 + 64 * kr_lo; tile_prefetch(kw, vw, Qk + kr0 * NAN3, Qk + kr0 * NAN3 + 2048, NAN3, tid); tile_commit_plain(kw, vw, lds, 0, tid); }
        for (int ti = 0; ti < nt; ++ti) {
            const bool loc = ti < nloc; const int kr = kr_lo + ti; const int boff = (ti & 1) * AT_BUF;
            if (ti + 1 < nt) { const size_t kr1 = (ti + 1 < nloc) ? lrow0 + 64 * (kr + 1) : crow0 + 64 * (ti + 1 - nloc); tile_prefetch(kw, vw, Qk + kr1 * NAN3, Qk + kr1 * NAN3 + 2048, NAN3, tid); }
            LDS_BARRIER();
            if (loc) {
                if (kr >= rsa && kr < rsb + 8) {
                    f32x16 p0; qkt32(p0, lds + boff + AT_K + cs * 256, qr, ka);
                    const LAS float* rp = RPB + (kr - r + 7) * 128 + 48 + (cs + 4 * hi - qc + 15);
                    int kb0 = cs + 4 * hi - wsq; asm volatile("" : "+v"(kb0));
                    const bool lrel = kr >= rsl && kr < rsl + 8;
                    if (!lrel) rp = RPB + 48;
                    float bb[16];
#pragma unroll
                    for (int rr = 0; rr < 16; ++rr) { const int kc = (rr & 3) + 8 * (rr >> 2); bb[rr] = *(const volatile LAS float*)(rp + kc); }
#pragma unroll
                    for (int rr = 0; rr < 16; ++rr) { const int kc = (rr & 3) + 8 * (rr >> 2); p0[rr] = (lrel && (unsigned)(kb0 + kc) < 16u) ? p0[rr] + bb[rr] : -INFINITY; }
                    sm_pv32(p0, o, m_reg, l_reg, vbs + boff, wsf + 32, r32, hi);
                }
            } else { f32x16 p0, p1; qkt_ka(p0, p1, lds + boff + AT_K, qr, ka); sm_pv(p0, p1, o, m_reg, l_reg, vb + boff, wsf + 32, r32, hi); }
            if (ti + 1 < nt) tile_commit_plain(kw, vw, lds, AT_BUF - boff, tid);
        }
        store_o(o, l_reg, Y + (size_t)(SEQL * b + 64 * ra + 16 * m) * DM + h * 128, wsf, lds + AT_OST + wave * 4096, lane, 64);
    }
    __syncthreads();
}
__device__ __forceinline__ void tail_share(int nwg, int G, int c, int& vc, int& VG) {
    const int rounds = (nwg + G - 1) / G; int c0 = nwg - (rounds - 1) * G;
    if (4 * (G - c0) < G) c0 = 0;
    VG = G - c0; vc = c - c0; if (vc < 0) vc = -1;
}
__global__ void __launch_bounds__(NWAVES * 64, 2) fwd_kernel(Args a) {
    extern __shared__ __attribute__((aligned(16))) unsigned char lds_raw[];
    LAS unsigned char* lds = (LAS unsigned char*)lds_raw;
    const int tid = threadIdx.x, lane = tid & 63, wave = __builtin_amdgcn_readfirstlane(tid >> 6), G = gridDim.x;
    unsigned char* ws = a.ws;
    volatile LAS unsigned* MISC = (volatile LAS unsigned*)(lds + MISC_OFF);
    for (int u = tid; u < (LDS_BYTES - LDSCTL_OFF) / 4; u += NWAVES * 64) ((LAS unsigned*)(lds + LDSCTL_OFF))[u] = 0u;
    __syncthreads();
    XcdBarrier bar = xcd_barrier_post((unsigned*)(ws + WS_CTL) + CW_BAR, MISC + 8);
#ifdef REP_RT
    const int lo = 0, hi = a.ph_hi;
#else
    const int lo = a.ph_lo, hi = a.ph_hi;
#endif
#define RUN(k) (lo <= (k) && (k) < hi)
#define SEAM(k) do { if (RUN(k) && RUN((k) + 1)) xcd_barrier(bar); } while (0)
#ifndef REP_MASK
#define REP_MASK 0u
#endif
#ifdef REP_RT
#define REPS(k) (int)(1u + (((unsigned)a.ph_lo >> (k)) & 1u))
#else
#define REPS(k) (int)(1u + ((REP_MASK >> (k)) & 1u))
#endif
#define REPS_UNUSED(k) (int)(1u + ((REP_MASK >> (k)) & 1u))
#ifdef TPROBE_S
    volatile LAS unsigned long long* TSL = (volatile LAS unsigned long long*)(lds + LDSCTL_OFF + 1024);
#define STAMP(k) do { if ((k) == TPROBE_S || (k) == TPROBE_E) { int t_ = threadIdx.x; asm volatile("" : "+v"(t_)); if (blockIdx.x == 0 && t_ == 0) TSL[k] = __builtin_amdgcn_s_memrealtime(); } } while (0)
#elif defined(PROBE)
    volatile LAS unsigned long long* TSL = (volatile LAS unsigned long long*)(lds + LDSCTL_OFF + 1024);
#define STAMP(k) do { if (blockIdx.x == 0 && tid == 0) { TSL[k] = __builtin_amdgcn_s_memrealtime(); TSL[32 + (k)] = __builtin_amdgcn_s_memtime(); } } while (0)
#else
#define STAMP(k) do { } while (0)
#endif
#ifdef CLKPROBE
    volatile LAS unsigned long long* CLK = (volatile LAS unsigned long long*)(lds + LDSCTL_OFF + 1024);
#endif
    bf16* X = (bf16*)(ws + WS_X)  ; bf16* PART = (bf16*)(ws + WS_BIG + 192 * MiB)  ; bf16* XC = X + (size_t)ML * DM; bf16* DL = (bf16*)(ws + WS_D); bf16* H = (bf16*)(ws + WS_H); bf16* BIG = (bf16*)(ws + WS_BIG); const float* MOD = (const float*)(ws + WS_MOD);

    STAMP(0); if (RUN(0)) for (int rep_ = 0; rep_ < REPS(0); ++rep_) {
                p0_misc(a, lds, tid, lane, wave, G);
                for (int st = -1; st < P0_NPRO; ++st) { p0_convert(a, lds, tid, (int)blockIdx.x, G, st, 0, p0_nitems(st)); if (st + 1 < P0_NPRO) { p0_absmax_phase(a, tid, (int)blockIdx.x, G, st + 1); xcd_barrier(bar); } } }
    SEAM(0);
    for (int s = 0; s < 4; ++s) {
        const int l = s >> 1, f = s & 1, pb = (s == 0) ? 1 : (s == 1) ? 9 : (s == 2) ? 12 : 19;
        const int Mrows = (s == 3) ? ML : MT;
        const float* modl = MOD + (size_t)l * 5 * MODW;
        STAMP(pb); if (RUN(pb)) for (int rep_ = 0; rep_ < REPS(pb); ++rep_) {
            const float* pgate = (s == 1) ? MOD + (size_t)5 * DM : (s == 2) ? MOD + (size_t)8 * DM : MOD + (size_t)(5 * 9 + 5) * DM;
            norm_phase((s == 0) ? (const void*)a.in[IN_X] : (const void*)X, s != 0, (s == 0) ? (const void*)a.in[IN_CTX] : (const void*)XC, s != 0, H, a.in[IN_NORMG] + (size_t)(l * 3 + 2 * f) * DM, modl, 6 * f, 6 * f + 1, Mrows, tid, G,
                       nullptr, (s == 1 || s == 2) ? PART : nullptr, pgate, (s == 2) ? 0.5f : 1.0f, (s == 0) ? X : nullptr, XC, (signed char*)H, (float*)(ws + WS_SH)); }
        SEAM(pb);
        STAMP(pb + 1); if (RUN(pb + 1)) for (int rep_ = 0; rep_ < REPS(pb + 1); ++rep_) { pg8::Gemm g{H, (const bf16*)(ws + WS_WFI + (size_t)s * FF2 * DM), Mrows, FF2, DM, (size_t)DM, 128, (size_t)DM, 128}; pg8::StaticOrder S; S.init(Mrows, FF2, G, (int)blockIdx.x, DM / 2, G1_WGM);
            pg8::EpiSwiGLUI8 E{BIG, MT, (const float*)(ws + WS_SH), (const float*)(ws + WS_CTL + CTL_WMAX_IN) + (size_t)s * FF2, FF, lds + LRU_U_OFF};
#ifdef CLKPROBE
            if (s == CLKPROBE && blockIdx.x == 0 && tid == 0) { CLK[0] = __builtin_amdgcn_s_memrealtime(); CLK[1] = __builtin_amdgcn_s_memtime(); }
#endif
            pg8::gemm_phase<pg8::EpiSwiGLUI8, pg8::StaticOrder, G1_ALIGN, GEMM_SP2>(lds, g, S, E);
#ifdef CLKPROBE
            if (s == CLKPROBE && blockIdx.x == 0 && tid == 0) { CLK[2] = __builtin_amdgcn_s_memrealtime(); CLK[3] = __builtin_amdgcn_s_memtime(); }
#endif
#if P0_NPRO < 5
            if (s < 3) { int vc, VG; tail_share(S.nwg, G, (int)blockIdx.x, vc, VG);
                if (vc >= 0) { if (s == 0) p0_absmax_phase(a, tid, vc, VG, 3);
                    else { const int nj = (s == 2) ? 2 : 1; for (int j = 0; j < nj; ++j) { const int st = j ? 4 : 3, jlo = (s == 2 && j == 0) ? P0_I_FI : 0, jhi = (s == 1) ? P0_I_FI : p0_nitems(st); p0_convert(a, lds, tid, vc, VG, st, jlo, jhi); } } } }
#endif
            xcd_barrier(bar); STAMP(24); hidden_quant_phase(BIG, (signed char*)(ws + WS_D), (float*)(ws + WS_SQ), Mrows, tid, G); }
        SEAM(pb + 1);
#ifdef IDLE_TEST
        if (s == 0) { const unsigned long long t0 = __builtin_amdgcn_s_memrealtime(); while (__builtin_amdgcn_s_memrealtime() - t0 < (unsigned long long)(IDLE_TEST * 100)) __builtin_amdgcn_s_sleep(32); __syncthreads(); }
#endif
        STAMP(pb + 2); if (RUN(pb + 2)) for (int rep_ = 0; rep_ < REPS(pb + 2); ++rep_) { pg8::Gemm g{(const bf16*)(ws + WS_D), (const bf16*)(ws + WS_WFO + (size_t)s * DM * HQP), Mrows, DM, 44 * 64, (size_t)HQP, 128, (size_t)HQP, 128}; pg8::CtxSplitOrder S; S.init(DM, G, (int)blockIdx.x, 44 * 64, s != 3, G2_WGM);
            pg8::EpiResidI8 E{X, (s == 3) ? (void*)a.out : (void*)X, s != 3, modl + (size_t)(6 * f + 2) * DM, 0.5f, PART, (const float*)(ws + WS_SQ), (const float*)(ws + WS_CTL + CTL_WMAX_OUT) + (size_t)s * DM}; pg8::gemm_phase<pg8::EpiResidI8, pg8::CtxSplitOrder, G2_ALIGN, GEMM_SP2>(lds, g, S, E); }
        SEAM(pb + 2);
        if (s == 0) {
            STAMP(4); if (RUN(4)) for (int rep_ = 0; rep_ < REPS(4); ++rep_) norm_phase(X, true, a.in[IN_CTX], false, H, a.in[IN_NORMG] + (size_t)(0 * 3 + 1) * DM, modl, 3, 4, MT, tid, G, nullptr, PART, MOD + (size_t)2 * DM, 0.5f, nullptr, XC, nullptr, nullptr);
            SEAM(4);
            STAMP(5); if (RUN(5)) for (int rep_ = 0; rep_ < REPS(5); ++rep_) { pg8::Gemm g = pg8::gemm_rr(H, (const bf16*)(ws + WS_WABI), MT, ABN, DM); pg8::StaticOrder S; S.init(MT, ABN, G, (int)blockIdx.x, DM);
                pg8::EpiQKRopeBf16 E{BIG, ABN, (const float*)(ws + WS_QKG), (const float*)(ws + WS_ROPE), (LAS float*)(lds + LRU_U_OFF)}; pg8::gemm_phase<pg8::EpiQKRopeBf16, pg8::StaticOrder, true, GEMM_SP2>(lds, g, S, E);
#if P0_NPRO < 5
                { int vc, VG; tail_share(S.nwg, G, (int)blockIdx.x, vc, VG); if (vc >= 0) p0_absmax_phase(a, tid, vc, VG, 4); }
#endif
            }
            SEAM(5);
            STAMP(6); if (RUN(6)) for (int rep_ = 0; rep_ < REPS(6); ++rep_) { lru_phase<false>(a, lds, tid, lane, wave, G); xcd_barrier(bar); lru_carry_scan(a, tid, G); }
            SEAM(6);
            STAMP(7); if (RUN(7)) for (int rep_ = 0; rep_ < REPS(7); ++rep_) { attn_ab_phase(a, lds, tid, lane, wave, G); STAMP(23);
                int vc, VG; tail_share(544, G, (int)blockIdx.x, vc, VG);
                lru_phase<true>(a, lds, tid, lane, wave, G, vc, VG, LRU_EXTRA * VG < 4 * 68 * 8 ? LRU_EXTRA * VG : 0); }
            SEAM(7);
            STAMP(8); if (RUN(8)) for (int rep_ = 0; rep_ < REPS(8); ++rep_) { pg8::Gemm g = pg8::gemm_rr(H, (const bf16*)(ws + WS_WABO), MT, DM, DM); pg8::CtxSplitOrder S; S.init(DM, G, (int)blockIdx.x, DM, true, G2_WGM);
                pg8::EpiResid E{X, XC, X, XC, modl + (size_t)5 * DM, 1.0f, PART}; pg8::gemm_phase<pg8::EpiResid, pg8::CtxSplitOrder, GEMM_ALIGN, GEMM_SP2>(lds, g, S, E); }
            SEAM(8);
        }
        if (s == 2) {
            STAMP(15); if (RUN(15)) for (int rep_ = 0; rep_ < REPS(15); ++rep_) norm_phase(X, true, XC, true, H, a.in[IN_NORMG] + (size_t)(1 * 3 + 1) * DM, modl, 3, 4, MT, tid, G, nullptr, PART, MOD + (size_t)(5 * 9 + 2) * DM, 0.5f, nullptr, XC, (signed char*)H, (float*)(ws + WS_SH));
            SEAM(15);
            STAMP(16); if (RUN(16)) for (int rep_ = 0; rep_ < REPS(16); ++rep_) {
                const float* sh = (const float*)(ws + WS_SH); const float* wmx = (const float*)(ws + WS_CTL + CTL_WMAX_NAI);
                { pg8::Gemm g{H, (const bf16*)(ws + WS_WNAI), ML, NAN3, DM, (size_t)DM, 128, (size_t)DM, 128}; pg8::StaticOrder S; S.init(ML, NAN3, G, (int)blockIdx.x, DM / 2);
                  pg8::EpiQKNormI8 E{BIG, NAN3, sh, wmx, a.in[IN_NAQN], a.in[IN_NAKN], 8, 8, (LAS float*)(lds + LRU_U_OFF)}; pg8::gemm_phase<pg8::EpiQKNormI8, pg8::StaticOrder, true, GEMM_SP2>(lds, g, S, E); }
                { pg8::Gemm g{(const bf16*)((const signed char*)H + (size_t)ML * DM), (const bf16*)(ws + WS_WNAI + (size_t)DM * DM), MC, 2 * DM, DM, (size_t)DM, 128, (size_t)DM, 128}; pg8::StaticOrder S; S.init(MC, 2 * DM, G, (int)blockIdx.x, DM / 2);
                  pg8::EpiQKNormI8 E{BIG + (size_t)ML * NAN3 + DM, NAN3, sh + ML, wmx + DM, a.in[IN_NAQN], a.in[IN_NAKN], 0, 8, (LAS float*)(lds + LRU_U_OFF)}; pg8::gemm_phase<pg8::EpiQKNormI8, pg8::StaticOrder, true, GEMM_SP2>(lds, g, S, E); }
            }
            SEAM(16);
            STAMP(17); if (RUN(17)) for (int rep_ = 0; rep_ < REPS(17); ++rep_) { attn_na_phase(a, lds, tid, lane, wave, G); xcd_barrier(bar); row_quant_phase(H, (signed char*)(ws + WS_D), (float*)(ws + WS_SY), ML, tid, G); }
            SEAM(17);
            STAMP(18); if (RUN(18)) for (int rep_ = 0; rep_ < REPS(18); ++rep_) { pg8::Gemm g{(const bf16*)(ws + WS_D), (const bf16*)(ws + WS_WNAO), ML, DM, DM, (size_t)DM, 128, (size_t)DM, 128}; pg8::CtxSplitOrder S; S.init(DM, G, (int)blockIdx.x, DM / 2, false, G2_WGM);
                pg8::EpiResidI8 E{X, X, 1, modl + (size_t)5 * DM, 1.0f, PART, (const float*)(ws + WS_SY), (const float*)(ws + WS_CTL + CTL_WMAX_NAO)}; pg8::gemm_phase<pg8::EpiResidI8, pg8::CtxSplitOrder, G2_ALIGN, GEMM_SP2>(lds, g, S, E); }
            SEAM(18);
        }
    }
#ifdef PROBE
    {
        xcd_barrier(bar); STAMP(22);
        float* slot = (float*)(ws + WS_CTL + 512 * 1024);
        if (blockIdx.x == 0 && tid == 0) { const float T1 = (float)(TSL[PROBE_E1] - TSL[PROBE_S1]) * 0.01f, T2 = (float)(TSL[PROBE_E2] - TSL[PROBE_S2]) * 0.01f;
#ifdef PROBE_CLOCK
            const float ghz = (float)(TSL[32 + PROBE_E1] - TSL[32 + PROBE_S1]) / ((float)(TSL[PROBE_E1] - TSL[PROBE_S1]) * 10.0f); const float sv = rintf(ghz * 10.0f + PROBE_CLOCK);
            __hip_atomic_store(slot, sv, RLX_AGENT); __hip_atomic_store(slot + 1, sv * 20.0f, RLX_AGENT); (void)T1; (void)T2; }
#else
            const float sv = sqrtf(T1); __hip_atomic_store(slot, sv, RLX_AGENT); __hip_atomic_store(slot + 1, sv * (10.0f + 0.8f * T2), RLX_AGENT); }
#endif
        xcd_barrier(bar);
        const float sv = __hip_atomic_load(slot, RLX_AGENT), V = __hip_atomic_load(slot + 1, RLX_AGENT);
        const f32x4* src = (const f32x4*)a.in[IN_X]; f32x4* dst = (f32x4*)a.out;
        for (size_t i = (size_t)blockIdx.x * (NWAVES * 64) + tid; i < (size_t)ML * DM / 4; i += (size_t)G * (NWAVES * 64)) { f32x4 v = src[i] * sv; if (i == 0) v.x = V; dst[i] = v; }
    }
#endif
#ifdef TPROBE_S
    { xcd_barrier(bar); STAMP(22);
      float* slot = (float*)(ws + WS_CTL + 512 * 1024);
      int t2_ = threadIdx.x; asm volatile("" : "+v"(t2_));
      if (blockIdx.x == 0 && t2_ == 0) { const float tus = (float)(TSL[TPROBE_E] - TSL[TPROBE_S]) * 0.01f; const float sv = rintf(tus * (1.0f / TPROBE_Q)); __hip_atomic_store(slot, sv * sv * 0.1f, RLX_AGENT); }
      xcd_barrier(bar);
      const float f = 1.0f + __hip_atomic_load(slot, RLX_AGENT) * 0.01f; f32x4* dst = (f32x4*)a.out;
      for (size_t i = (size_t)blockIdx.x * (NWAVES * 64) + tid; i < (size_t)ML * DM / 4; i += (size_t)G * (NWAVES * 64)) dst[i] = dst[i] * f; }
#endif
#ifdef CLKPROBE
    { xcd_barrier(bar);
      float* slot = (float*)(ws + WS_CTL + 512 * 1024);
      if (blockIdx.x == 0 && tid == 0) { const float ghz = (float)(CLK[3] - CLK[1]) / ((float)(CLK[2] - CLK[0]) * 10.0f); const float tus = (float)(CLK[2] - CLK[0]) * 0.01f;
#ifdef CLKPROBE_T
        const float sv = rintf(tus * (1.0f / CLKPROBE_T)); (void)ghz;
#else
        const float sv = rintf(ghz * 8.0f); (void)tus;
#endif
        __hip_atomic_store(slot, sv * sv * 0.1f, RLX_AGENT); }
      xcd_barrier(bar);
      const float f = 1.0f + __hip_atomic_load(slot, RLX_AGENT) * 0.01f; f32x4* dst = (f32x4*)a.out;
      for (size_t i = (size_t)blockIdx.x * (NWAVES * 64) + tid; i < (size_t)ML * DM / 4; i += (size_t)G * (NWAVES * 64)) dst[i] = dst[i] * f; }
#endif
    if (hi < N_PHASES) {
        xcd_barrier(bar);
        const f32x4* src = (const f32x4*)a.in[IN_X]; f32x4* dst = (f32x4*)a.out;
        for (size_t i = (size_t)blockIdx.x * (NWAVES * 64) + tid; i < (size_t)ML * DM / 4; i += (size_t)G * (NWAVES * 64)) dst[i] = src[i];
    }
#undef RUN
#undef SEAM
}

extern "C" void kernel_launch(void* const* d_in, const int* in_sizes, int n_in, void* d_out, int out_size, void* d_ws, size_t ws_size, hipStream_t stream) {
    static int grid = 0;
    if (grid == 0) {
        if (n_in != 26 || in_sizes[0] != ML * DM || out_size != ML * DM || ws_size < WS_END) { fprintf(stderr, "kernel_launch: shape mismatch: n_in %d in0 %d out %d ws %zu (need %zu)\n", n_in, n_in > 0 ? in_sizes[0] : -1, out_size, ws_size, (size_t)WS_END); grid = -1; return; }
        int dev = 0, cus = 0, per_cu = 0;
        if (hipGetDevice(&dev) != hipSuccess || hipDeviceGetAttribute(&cus, hipDeviceAttributeMultiprocessorCount, dev) != hipSuccess) { grid = -1; return; }
        if (hipFuncSetAttribute((const void*)fwd_kernel, hipFuncAttributeMaxDynamicSharedMemorySize, LDS_BYTES) != hipSuccess) { fprintf(stderr, "kernel_launch: hipFuncSetAttribute failed\n"); grid = -1; return; }
        if (hipOccupancyMaxActiveBlocksPerMultiprocessor(&per_cu, (const void*)fwd_kernel, NWAVES * 64, LDS_BYTES) != hipSuccess || per_cu < 1) fprintf(stderr, "kernel_launch: occupancy query says %d\n", per_cu);
        (void)hipGetLastError();
        grid = cus;
    }
    if (grid < 0) return;
    if (hipMemsetAsync((char*)d_ws + WS_CTL, 0, CTL_ZERO_BYTES, stream) != hipSuccess) return;
    Args a{};
    for (int i = 0; i < 26; ++i) a.in[i] = (const float*)d_in[i];
    a.out = (float*)d_out; a.ws = (unsigned char*)d_ws; a.ph_lo = 0; a.ph_hi = NPHASES_RUN;
#ifdef REP_RT
    a.ph_lo = (int)(REP_RT);
#endif
#ifdef PROBE
    for (int rep = 0; rep < 2; ++rep) { hipLaunchKernelGGL(fwd_kernel, dim3(grid), dim3(NWAVES * 64), LDS_BYTES, stream, a); (void)hipMemsetAsync((char*)d_ws + WS_CTL, 0, CTL_ZERO_BYTES, stream); }
#endif
    hipLaunchKernelGGL(fwd_kernel, dim3(grid), dim3(NWAVES * 64), LDS_BYTES, stream, a);
    const hipError_t le = hipPeekAtLastError();
    if (le != hipSuccess) fprintf(stderr, "kernel_launch: launch failed: %s\n", hipGetErrorName(le));
}
```
